# Optimizing an MI355X kernel written in HIP

```python
import math
import jax, jax.numpy as jnp
from jax import lax
import numpy as np

D_MODEL = 1024
BATCH = 2
SEQ = 16384
DEPTH = 2

N_MIXERS = 2
N_HYENA_LAYERS = (DEPTH + N_MIXERS - 1) // N_MIXERS
N_NA_LAYERS = DEPTH // N_MIXERS
GRID_W = 64
RMS_EPS = 1e-6
HY_SHORT_CONV = 3
HY_EMB_DIM = 33
HY_N_BANDS = (HY_EMB_DIM - 1) // 2
HY_FILTER_WIDTH = 64
HY_FAST_DECAY_PCT = 0.3
HY_SLOW_DECAY_PCT = 1.5
HY_DECAY_TARGET = 1e-2
NA_HEADS = 16
NA_HEAD_DIM = D_MODEL // NA_HEADS
NA_KH = 8
NA_KW = 16
FFN_HIDDEN = -(-8 * D_MODEL // (3 * 256)) * 256

kernel_name = "hybrid_hyena_natten_encoder"


def rmsnorm(x, g):
    x32 = x.astype(jnp.float32)
    y = x32 * lax.rsqrt(jnp.mean(x32 * x32, axis=-1, keepdims=True) + RMS_EPS)
    return (y * g.astype(jnp.float32)).astype(x.dtype)


def short_conv(z, w, b):
    c = z.shape[-1]
    pad = HY_SHORT_CONV // 2
    y = lax.conv_general_dilated(
        z, w[:, None, :].astype(z.dtype), window_strides=(1,), padding=((pad, pad),),
        dimension_numbers=("NWC", "WIO", "NWC"), feature_group_count=c)
    return y + b


def hyena_filter(L, w1, b1, w2, b2, w3, b3, freq, w_out, decay):
    f32 = jnp.float32
    t = jnp.linspace(0.0, 1.0, L, dtype=f32)[:, None]
    w = 2.0 * math.pi * jnp.arange(L, dtype=f32)[:, None] / L
    bands = jnp.linspace(1e-4, HY_N_BANDS - 1, HY_N_BANDS, dtype=f32)[None, :]
    feat = jnp.concatenate([t, jnp.cos(bands * w), -jnp.sin(bands * w)], axis=-1)
    fr = freq.astype(f32)
    act = lambda a: jnp.sin(fr * a)
    h = act(feat @ w1.astype(f32) + b1.astype(f32))
    h = act(h @ w2.astype(f32) + b2.astype(f32))
    h = act(h @ w3.astype(f32) + b3.astype(f32))
    h = (h @ w_out.astype(f32)).reshape(L, 2, D_MODEL)
    h = h * jnp.exp(-t[:, :, None] * jnp.abs(decay.astype(f32)))
    g = jnp.concatenate([h[:, 0], jnp.zeros((1, D_MODEL), f32), jnp.flip(h[1:, 1], axis=0)], axis=0)
    return g / jnp.sum(jnp.abs(g), axis=0, keepdims=True)


def hyena_mixer(u, w_in, b_in, conv_w, conv_b, f_w1, f_b1, f_w2, f_b2, f_w3, f_b3,
                f_freq, f_wout, decay, skip, w_out, b_out):
    L = u.shape[1]
    z = short_conv(u @ w_in + b_in, conv_w, conv_b)
    x0, x1, v = jnp.split(z, 3, axis=-1)
    s = (v * x1).astype(jnp.float32)
    g = hyena_filter(L, f_w1, f_b1, f_w2, f_b2, f_w3, f_b3, f_freq, f_wout, decay)
    n = 2 * L
    y = jnp.fft.irfft(jnp.fft.rfft(s, n=n, axis=1) * jnp.fft.rfft(g, n=n, axis=0)[None],
                      n=n, axis=1)[:, :L]
    y = (y + s * skip.astype(jnp.float32)).astype(u.dtype) * x0
    return y @ w_out + b_out


def na_mixer(u, w_qkv, b_qkv, rpb, w_o, b_o):
    B_, L, D = u.shape
    rows = L // GRID_W
    kh = min(NA_KH, rows)
    kw = NA_KW
    qkv = u @ w_qkv + b_qkv
    q, k, v = [a.reshape(B_, rows, GRID_W, NA_HEADS, NA_HEAD_DIM) for a in jnp.split(qkv, 3, axis=-1)]
    q = q * (NA_HEAD_DIM ** -0.5)
    col = jnp.arange(GRID_W)
    col_start = jnp.clip(col - kw // 2, 0, GRID_W - kw)
    col_idx = col_start[:, None] + jnp.arange(kw)[None, :]
    col_off = col_idx - col[:, None] + (NA_KW - 1)

    def row_block(r):
        r_start = jnp.clip(r - kh // 2, 0, rows - kh)
        k_rows = lax.dynamic_slice_in_dim(k, r_start, kh, axis=1)
        v_rows = lax.dynamic_slice_in_dim(v, r_start, kh, axis=1)
        k_win = k_rows[:, :, col_idx]
        v_win = v_rows[:, :, col_idx]
        q_r = lax.dynamic_index_in_dim(q, r, axis=1, keepdims=False)
        s = jnp.einsum("bwhd,biwjhd->bhwij", q_r, k_win)
        row_off = r_start + jnp.arange(kh) - r + (NA_KH - 1)
        bias = rpb[:, row_off[None, :, None], col_off[:, None, :]]
        s = (s + bias[None]).astype(jnp.float32).reshape(B_, NA_HEADS, GRID_W, kh * kw)
        p = jax.nn.softmax(s, axis=-1).reshape(B_, NA_HEADS, GRID_W, kh, kw).astype(v.dtype)
        return jnp.einsum("bhwij,biwjhd->bwhd", p, v_win)

    out = lax.map(row_block, jnp.arange(rows))
    out = jnp.transpose(out, (1, 0, 2, 3, 4)).reshape(B_, L, D)
    return out @ w_o + b_o


def swiglu(x, w_gate, w_up, w_down):
    return (jax.nn.silu(x @ w_gate) * (x @ w_up)) @ w_down


def setup_inputs(seed: int = 0) -> dict:
    key = jax.random.key(seed)
    ks = iter(jax.random.split(key, 40))
    nrm = lambda shape, scale: scale * jax.random.normal(next(ks), shape, jnp.float32)
    D, F, NH, NN = D_MODEL, FFN_HIDDEN, N_HYENA_LAYERS, N_NA_LAYERS
    base_decay = jnp.abs(jnp.linspace(math.log(HY_DECAY_TARGET) / HY_SLOW_DECAY_PCT,
                                      math.log(HY_DECAY_TARGET) / HY_FAST_DECAY_PCT, D, dtype=jnp.float32))
    return {
        "x": nrm((BATCH, SEQ, D), 1.0),
        "norm_mix": 1.0 + nrm((DEPTH, D), 0.02),
        "norm_ffn": 1.0 + nrm((DEPTH, D), 0.02),
        "norm_final": 1.0 + nrm((D,), 0.02),
        "hy_w_in": nrm((NH, D, 3 * D), D ** -0.5),
        "hy_b_in": nrm((NH, 3 * D), 0.02),
        "hy_conv_w": nrm((NH, HY_SHORT_CONV, 3 * D), HY_SHORT_CONV ** -0.5),
        "hy_conv_b": nrm((NH, 3 * D), 0.02),
        "hy_f_w1": nrm((NH, HY_EMB_DIM, HY_FILTER_WIDTH), HY_EMB_DIM ** -0.5),
        "hy_f_b1": nrm((NH, HY_FILTER_WIDTH), 0.02),
        "hy_f_w2": nrm((NH, HY_FILTER_WIDTH, HY_FILTER_WIDTH), HY_FILTER_WIDTH ** -0.5),
        "hy_f_b2": nrm((NH, HY_FILTER_WIDTH), 0.02),
        "hy_f_w3": nrm((NH, HY_FILTER_WIDTH, HY_FILTER_WIDTH), HY_FILTER_WIDTH ** -0.5),
        "hy_f_b3": nrm((NH, HY_FILTER_WIDTH), 0.02),
        "hy_f_freq": 1.0 + nrm((NH, HY_FILTER_WIDTH), 0.02),
        "hy_f_wout": nrm((NH, HY_FILTER_WIDTH, 2 * D), HY_FILTER_WIDTH ** -0.5),
        "hy_decay": base_decay * (1.0 + nrm((NH, 2, D), 0.05)),
        "hy_skip": nrm((NH, D), 0.5),
        "hy_w_out": nrm((NH, D, D), D ** -0.5),
        "hy_b_out": nrm((NH, D), 0.02),
        "na_w_qkv": nrm((NN, D, 3 * D), D ** -0.5),
        "na_b_qkv": nrm((NN, 3 * D), 0.02),
        "na_rpb": nrm((NN, NA_HEADS, 2 * NA_KH - 1, 2 * NA_KW - 1), 0.02),
        "na_w_o": nrm((NN, D, D), D ** -0.5),
        "na_b_o": nrm((NN, D), 0.02),
        "ffn_w_gate": nrm((DEPTH, D, F), D ** -0.5),
        "ffn_w_up": nrm((DEPTH, D, F), D ** -0.5),
        "ffn_w_down": nrm((DEPTH, F, D), F ** -0.5),
    }


def reference(x, norm_mix, norm_ffn, norm_final,
              hy_w_in, hy_b_in, hy_conv_w, hy_conv_b, hy_f_w1, hy_f_b1, hy_f_w2, hy_f_b2,
              hy_f_w3, hy_f_b3, hy_f_freq, hy_f_wout, hy_decay, hy_skip, hy_w_out, hy_b_out,
              na_w_qkv, na_b_qkv, na_rpb, na_w_o, na_b_o,
              ffn_w_gate, ffn_w_up, ffn_w_down):
    for i in range(DEPTH):
        h = rmsnorm(x, norm_mix[i])
        j = i // N_MIXERS
        if i % N_MIXERS == 0:
            mixed = hyena_mixer(h, hy_w_in[j], hy_b_in[j], hy_conv_w[j], hy_conv_b[j],
                                hy_f_w1[j], hy_f_b1[j], hy_f_w2[j], hy_f_b2[j], hy_f_w3[j], hy_f_b3[j],
                                hy_f_freq[j], hy_f_wout[j], hy_decay[j], hy_skip[j],
                                hy_w_out[j], hy_b_out[j])
        else:
            mixed = na_mixer(h, na_w_qkv[j], na_b_qkv[j], na_rpb[j], na_w_o[j], na_b_o[j])
        x = x + mixed
        x = x + swiglu(rmsnorm(x, norm_ffn[i]), ffn_w_gate[i], ffn_w_up[i], ffn_w_down[i])
    return rmsnorm(x, norm_final)
```

```cpp
#include <hip/hip_runtime.h>
#include <hip/hip_cooperative_groups.h>
#include <cstdio>
#include <cstdint>
namespace cg = cooperative_groups;
#ifndef MK_SINGLE
#define MK_SINGLE 1
#endif
namespace pg8 {
#define PG8_LAS __attribute__((address_space(3)))
typedef unsigned short bf16_t;
typedef short bf16x8 __attribute__((ext_vector_type(8)));
typedef float f32x4 __attribute__((ext_vector_type(4)));
typedef unsigned u32x4 __attribute__((ext_vector_type(4)));
constexpr int BM = 256, BK = 64, HALF = 128, HTB = HALF * BK * 2  , STAGE_BYTES = 8 * HTB, NXCD = 8, WGM = 8;

__host__ __device__ __forceinline__ int lds_byte(int r, int c) { const int st = (r >> 4) * 2 + (c >> 5), rr = r & 15, cc = c & 31, ob = rr * 64 + cc * 2; return st * 1024 + (ob ^ (((ob >> 9) & 1) << 5)); }
__host__ __device__ __forceinline__ void stage_rc(int b, int& R, int& C) { const int st = b / 1024, sb = b % 1024, swz = sb ^ (((sb >> 9) & 1) << 5); R = (st >> 1) * 16 + swz / 64; C = (st & 1) * 32 + (swz % 64) / 2; }
__host__ __device__ __forceinline__ int perm32(int rho) { const int n = rho >> 4, i = rho & 15; return 8 * (i >> 2) + 4 * n + (i & 3); }

struct Unit { int pm, pn; };
struct Gemm { const bf16_t* A; const bf16_t* Bt; int M, N, K; };

struct StaticOrder {
    int nM, nN, nwg, G, c;
    __host__ __device__ void init(int M, int N, int G_, int c_) { nM = M / BM; nN = N / BM; nwg = nM * nN; G = G_; c = c_; }
    __host__ __device__ bool next(int i, Unit& u) const {
        const long L = (long)i * G + c; if (L >= nwg) return false;
        int wgid = (int)L; { const int q = nwg / NXCD, r = nwg % NXCD, xcd = wgid % NXCD, off = wgid / NXCD; wgid = (xcd < r ? xcd * (q + 1) : r * (q + 1) + (xcd - r) * q) + off; }
        const int nig = WGM * nN, gid = wgid / nig, fm = gid * WGM, gsz = (nM - fm) < WGM ? (nM - fm) : WGM;
        u.pm = fm + ((wgid % nig) % gsz); u.pn = (wgid % nig) / gsz; return true;
    }
    __device__ __forceinline__ void a_ready(const Unit&) const {}
    __device__ __forceinline__ void done(const Unit&) const {}
};

__device__ __forceinline__ unsigned cvt_pk_bf16(float lo, float hi) { unsigned r; asm volatile("v_cvt_pk_bf16_f32 %0, %1, %2" : "=v"(r) : "v"(lo), "v"(hi)); return r; }
typedef float f32x2 __attribute__((ext_vector_type(2)));
typedef unsigned u32x4v __attribute__((ext_vector_type(4)));
__device__ __forceinline__ u32x4v pack8(const f32x4& a, const f32x4& b) { u32x4v w; w.x = cvt_pk_bf16(a[0], a[1]); w.y = cvt_pk_bf16(a[2], a[3]); w.z = cvt_pk_bf16(b[0], b[1]); w.w = cvt_pk_bf16(b[2], b[3]); return w; }
__device__ __forceinline__ float rstd_from_partials(const float* part, int row) {
    const f32x4* p = (const f32x4*)(part + (size_t)row * 16); const f32x4 a = p[0], b = p[1], c = p[2], d = p[3];
    const float s = ((a[0] + a[1]) + (a[2] + a[3])) + ((b[0] + b[1]) + (b[2] + b[3])) + ((c[0] + c[1]) + (c[2] + c[3])) + ((d[0] + d[1]) + (d[2] + d[3]));
    return __builtin_amdgcn_rsqf(s * (1.0f / 1024.0f) + 1e-6f);
}
template <int MODE> struct EpiT {
    static constexpr bool PERM = true, AFTER_DRAIN = false;
    bf16_t* O; int ldc; const float* rvec; const float* cscale; float kdec;
    __device__ __forceinline__ void operator()(const f32x4 (&acc)[2][2][4][2], const Unit& u, int wr, int wc, int fr, int fq) const {
        const int row0 = u.pm * BM + wr * 64 + fr, col0 = u.pn * BM + wc * 32 + 8 * fq;
        f32x4 cs[2][2];
        if (MODE == 1) {
#pragma unroll
            for (int bj = 0; bj < 2; ++bj)
#pragma unroll
                for (int n = 0; n < 2; ++n) cs[bj][n] = *(const f32x4*)(cscale + col0 + bj * HALF + 4 * n);
        }
#pragma unroll
        for (int ai = 0; ai < 2; ++ai)
#pragma unroll
            for (int m = 0; m < 4; ++m) { const int r = row0 + ai * HALF + m * 16; const float rv = rvec[r]; bf16_t* rowp = O + (size_t)r * ldc + col0;
                const float rk = (MODE == 2) ? fabsf(rv) * kdec : 0.f;
#pragma unroll
                for (int bj = 0; bj < 2; ++bj) { f32x4 v0 = acc[ai][bj][m][0], v1 = acc[ai][bj][m][1];
                    if (MODE == 0) { v0 = v0 + rv; v1 = v1 + rv; }
                    if (MODE == 1) { v0 = v0 * cs[bj][0] + rv; v1 = v1 * cs[bj][1] + rv; }
                    if (MODE == 2) { const float cb = (float)(col0 + bj * HALF);
#pragma unroll
                        for (int e = 0; e < 4; ++e) { v0[e] *= __builtin_amdgcn_exp2f(-(cb + (float)e) * rk); v1[e] *= __builtin_amdgcn_exp2f(-(cb + (float)(4 + e)) * rk); } }
                    if (MODE == 1) {
                        const int mtok = col0 + bj * HALF; const size_t o = ((((size_t)(r >> 6) * 512 + (mtok >> 6)) * 8 + ((mtok & 63) >> 3)) * 64 + (r & 63)) * 8;
                        *(u32x4v*)(O + o) = pack8(v0, v1);
                    } else
                    *(u32x4v*)(rowp + bj * HALF) = pack8(v0, v1); } }
    }
};
struct EpiRowScale {
    static constexpr bool PERM = true, AFTER_DRAIN = false;
    bf16_t* O; int ldc; const float* bias; const float* rstd;
    __device__ __forceinline__ void operator()(const f32x4 (&acc)[2][2][4][2], const Unit& u, int wr, int wc, int fr, int fq) const {
        const int row0 = u.pm * BM + wr * 64 + fr, col0 = u.pn * BM + wc * 32 + 8 * fq;
        f32x4 bv[2][2];
#pragma unroll
        for (int bj = 0; bj < 2; ++bj)
#pragma unroll
            for (int n = 0; n < 2; ++n) bv[bj][n] = *(const f32x4*)(bias + col0 + bj * HALF + 4 * n);
#pragma unroll
        for (int ai = 0; ai < 2; ++ai)
#pragma unroll
            for (int m = 0; m < 4; ++m) { const int r = row0 + ai * HALF + m * 16; const float rs = rstd[r]; bf16_t* rowp = O + (size_t)r * ldc + col0;
#pragma unroll
                for (int bj = 0; bj < 2; ++bj) { const f32x4 v0 = acc[ai][bj][m][0] * rs + bv[bj][0], v1 = acc[ai][bj][m][1] * rs + bv[bj][1];
                    const int c = col0 + bj * HALF;
                    (void)rowp; *(u32x4v*)(O + (((size_t)(c >> 6) * 2 + ((c >> 5) & 1)) * 32768 + r) * 32 + (c & 31)) = pack8(v0, v1); } }
    }
};
template <bool BASE_F32> struct EpiRes {
    static constexpr bool PERM = true, AFTER_DRAIN = false;
    const float* base; bf16_t* xb; const float* bias; float* part;
    __device__ __forceinline__ void operator()(const f32x4 (&acc)[2][2][4][2], const Unit& u, int wr, int wc, int fr, int fq) const {
        const int row0 = u.pm * BM + wr * 64 + fr, col0 = u.pn * BM + wc * 32 + 8 * fq;
        f32x4 bv[2][2];
#pragma unroll
        for (int bj = 0; bj < 2; ++bj)
#pragma unroll
            for (int n = 0; n < 2; ++n) bv[bj][n] = bias ? *(const f32x4*)(bias + col0 + bj * HALF + 4 * n) : (f32x4){0.f, 0.f, 0.f, 0.f};
#pragma unroll
        for (int ai = 0; ai < 2; ++ai)
#pragma unroll
            for (int m = 0; m < 4; ++m) { const int r = row0 + ai * HALF + m * 16; const size_t off = (size_t)r * 1024 + col0; float ss = 0.f;
#pragma unroll
                for (int bj = 0; bj < 2; ++bj) {
                    f32x4 b0, b1;
                    if (BASE_F32) { b0 = *(const f32x4*)(base + off + bj * HALF); b1 = *(const f32x4*)(base + off + bj * HALF + 4); }
                    else { const u32x4v w = *(const u32x4v*)(xb + off + bj * HALF);
                        b0 = (f32x4){__uint_as_float(w.x << 16), __uint_as_float(w.x & 0xffff0000u), __uint_as_float(w.y << 16), __uint_as_float(w.y & 0xffff0000u)};
                        b1 = (f32x4){__uint_as_float(w.z << 16), __uint_as_float(w.z & 0xffff0000u), __uint_as_float(w.w << 16), __uint_as_float(w.w & 0xffff0000u)}; }
                    const f32x4 v0 = acc[ai][bj][m][0] + bv[bj][0] + b0, v1 = acc[ai][bj][m][1] + bv[bj][1] + b1;
                    *(u32x4v*)(xb + off + bj * HALF) = pack8(v0, v1);
                    ss += (v0[0] * v0[0] + v0[1] * v0[1]) + (v0[2] * v0[2] + v0[3] * v0[3]) + (v1[0] * v1[0] + v1[1] * v1[1]) + (v1[2] * v1[2] + v1[3] * v1[3]); }
                ss += __shfl_xor(ss, 16); ss += __shfl_xor(ss, 32);
                if (fq == 0) part[(size_t)r * 16 + u.pn * 4 + wc] = ss; }
    }
};
struct EpiGU {
    static constexpr bool PERM = true, AFTER_DRAIN = false;
    bf16_t* H; const float* part;
    __device__ __forceinline__ void operator()(const f32x4 (&acc)[2][2][4][2], const Unit& u, int wr, int wc, int fr, int fq) const {
        const int row0 = u.pm * BM + wr * 64 + fr, hc0 = u.pn * HALF + wc * 32 + 8 * fq;
#pragma unroll
        for (int ai = 0; ai < 2; ++ai)
#pragma unroll
            for (int m = 0; m < 4; ++m) { const int r = row0 + ai * HALF + m * 16; const float rs = rstd_from_partials(part, r);
                f32x4 o[2];
#pragma unroll
                for (int n = 0; n < 2; ++n) { const f32x4 g = acc[ai][0][m][n] * rs, up = acc[ai][1][m][n] * rs;
#pragma unroll
                    for (int e = 0; e < 4; ++e) o[n][e] = g[e] * __builtin_amdgcn_rcpf(1.0f + __builtin_amdgcn_exp2f(-1.44269504089f * g[e])) * up[e]; }
                *(u32x4v*)(H + (size_t)r * 2816 + hc0) = pack8(o[0], o[1]); }
    }
};
template <class Epi, class Sched, bool ALIGN_EPI = false, bool SP2 = false>
__device__ __forceinline__ void gemm_phase(PG8_LAS unsigned char* lds, const Gemm g, const Sched& S, const Epi& E) {
    const int tid = threadIdx.x, wid = __builtin_amdgcn_readfirstlane(tid >> 6), lane = tid & 63, wr = wid >> 2, wc = wid & 3, fr = lane & 15, fq = lane >> 4;
    const int K = g.K, nt = K / BK;
    unsigned voffA[2], voffB[2];
#pragma unroll
    for (int i = 0; i < 2; ++i) { int R, C; stage_rc(tid * 16 + i * 8192, R, C); const int Rb = Epi::PERM ? ((R & ~31) + perm32(R & 31)) : R;
        voffA[i] = (unsigned)(R * K + C) * 2u; voffB[i] = (unsigned)(Rb * K + C) * 2u; }
    const size_t kstep = (size_t)(BK * 2);
    const size_t hstep = (size_t)HALF * K * 2;
    const size_t tstep = 2 * hstep;
    const unsigned ldsw = (unsigned)wid * 1024u;
    const int aoff = lds_byte(wr * 64 + fr, fq * 8), boff = lds_byte(wc * 32 + fr, fq * 8);
#define PG8_SA(b, h) (((b) * 2 + (h)) * HTB)
#define PG8_SB(b, h) ((4 + (b) * 2 + (h)) * HTB)
#define PG8_STAGE(bufoff, gbase, voff) do { _Pragma("unroll") for (int _i = 0; _i < 2; ++_i) \
        __builtin_amdgcn_global_load_lds((const unsigned*)((const char*)(gbase) + (voff)[_i]), (PG8_LAS unsigned*)(lds + (bufoff) + ldsw + _i * 8192), 16, 0, 0); } while (0)
#define PG8_LDA(dst, b, h) do { _Pragma("unroll") for (int m = 0; m < 4; ++m) _Pragma("unroll") for (int k = 0; k < 2; ++k) dst[m][k] = *(const PG8_LAS bf16x8*)(lds + PG8_SA(b, h) + aoff + m * 2048 + k * 1024); } while (0)
#define PG8_LDB(dst, b, h) do { _Pragma("unroll") for (int n = 0; n < 2; ++n) _Pragma("unroll") for (int k = 0; k < 2; ++k) dst[n][k] = *(const PG8_LAS bf16x8*)(lds + PG8_SB(b, h) + boff + n * 2048 + k * 1024); } while (0)
#define PG8_MMA(ai, bj, At, Bt) do { __builtin_amdgcn_s_setprio(1); _Pragma("unroll") for (int m = 0; m < 4; ++m) _Pragma("unroll") for (int n = 0; n < 2; ++n) _Pragma("unroll") for (int k = 0; k < 2; ++k) \
        acc[ai][bj][m][n] = __builtin_amdgcn_mfma_f32_16x16x32_bf16(Bt[n][k], At[m][k], acc[ai][bj][m][n], 0, 0, 0); __builtin_amdgcn_s_setprio(0); } while (0)
#define PG8_WAIT_V(n) asm volatile("s_waitcnt vmcnt(" #n ")" ::: "memory")
#define PG8_WAIT_L(n) asm volatile("s_waitcnt lgkmcnt(" #n ")" ::: "memory")
#define PG8_BAR __builtin_amdgcn_s_barrier()
#define PG8_SCHED __builtin_amdgcn_sched_barrier(0)
    Unit cur, nxt; int ui = 0;
    if (!S.next(0, cur)) return;
    f32x4 acc[2][2][4][2];
#pragma unroll
    for (int a = 0; a < 2; ++a)
#pragma unroll
        for (int b = 0; b < 2; ++b)
#pragma unroll
            for (int m = 0; m < 4; ++m)
#pragma unroll
                for (int n = 0; n < 2; ++n) acc[a][b][m][n] = (f32x4){0.f, 0.f, 0.f, 0.f};
    bf16x8 At[4][2], B0[2][2], B1[2][2];
    const char* cA = (const char*)g.A + (size_t)cur.pm * tstep; const char* cB = (const char*)g.Bt + (size_t)cur.pn * tstep;
    S.a_ready(cur);
    if constexpr (SP2) {
        PG8_STAGE(PG8_SB(0, 0), cB, voffB); PG8_STAGE(PG8_SB(0, 1), cB + hstep, voffB); PG8_STAGE(PG8_SA(0, 0), cA, voffA); PG8_STAGE(PG8_SA(0, 1), cA + hstep, voffA);
        if (wr == 1) PG8_BAR;
        PG8_WAIT_V(2); PG8_BAR;
        PG8_STAGE(PG8_SB(1, 0), cB + kstep, voffB); PG8_STAGE(PG8_SA(1, 0), cA + kstep, voffA); PG8_STAGE(PG8_SB(1, 1), cB + hstep + kstep, voffB);
        PG8_WAIT_V(6); PG8_BAR;
    } else {
        PG8_STAGE(PG8_SB(0, 0), cB, voffB); PG8_STAGE(PG8_SA(0, 0), cA, voffA); PG8_STAGE(PG8_SB(0, 1), cB + hstep, voffB); PG8_STAGE(PG8_SA(0, 1), cA + hstep, voffA);
        if (wr == 1) PG8_BAR;
        PG8_WAIT_V(4); PG8_BAR;
        PG8_STAGE(PG8_SB(1, 0), cB + kstep, voffB); PG8_STAGE(PG8_SA(1, 0), cA + kstep, voffA); PG8_STAGE(PG8_SB(1, 1), cB + hstep + kstep, voffB);
        PG8_WAIT_V(6); PG8_BAR;
    }
    for (;;) {
        const bool has_next = S.next(ui + 1, nxt);
        const char* nA = has_next ? (const char*)g.A + (size_t)nxt.pm * tstep : cA; const char* nB = has_next ? (const char*)g.Bt + (size_t)nxt.pn * tstep : cB;
        for (int t = 0; t < nt; t += 2) {
            const bool last = (t == nt - 2);
            const char* a1 = cA + (size_t)(t + 1) * kstep;
            const char* a2 = last ? nA : cA + (size_t)(t + 2) * kstep; const char* b2 = last ? nB : cB + (size_t)(t + 2) * kstep;
            const char* a3 = a2 + kstep; const char* b3 = b2 + kstep;
            if (last && has_next) S.a_ready(nxt);
            if constexpr (SP2) {
            PG8_LDB(B0, 0, 0); PG8_LDB(B1, 0, 1); PG8_SCHED; PG8_LDA(At, 0, 0); PG8_STAGE(PG8_SA(1, 1), a1 + hstep, voffA);
            PG8_WAIT_V(8); PG8_WAIT_L(0); PG8_BAR; PG8_MMA(0, 0, At, B0); PG8_MMA(0, 1, At, B1); PG8_BAR; PG8_SCHED;
            PG8_LDA(At, 0, 1); PG8_STAGE(PG8_SB(0, 0), b2, voffB); PG8_STAGE(PG8_SB(0, 1), b2 + hstep, voffB); PG8_STAGE(PG8_SA(0, 0), a2, voffA);
            PG8_WAIT_V(8); PG8_WAIT_L(0); PG8_BAR; PG8_MMA(1, 0, At, B0); PG8_MMA(1, 1, At, B1); PG8_BAR; PG8_SCHED;
            PG8_LDB(B0, 1, 0); PG8_LDB(B1, 1, 1); PG8_SCHED; PG8_LDA(At, 1, 0); PG8_STAGE(PG8_SA(0, 1), a2 + hstep, voffA);
            PG8_WAIT_V(8); PG8_WAIT_L(0); PG8_BAR; PG8_MMA(0, 0, At, B0); PG8_MMA(0, 1, At, B1); PG8_BAR; PG8_SCHED;
            PG8_LDA(At, 1, 1); PG8_STAGE(PG8_SB(1, 0), b3, voffB); PG8_STAGE(PG8_SB(1, 1), b3 + hstep, voffB); PG8_STAGE(PG8_SA(1, 0), a3, voffA);
            PG8_WAIT_V(8); PG8_WAIT_L(0); PG8_BAR; PG8_MMA(1, 0, At, B0); PG8_MMA(1, 1, At, B1); PG8_BAR; PG8_SCHED;
            } else {
            PG8_LDB(B0, 0, 0); PG8_SCHED; PG8_LDA(At, 0, 0); PG8_STAGE(PG8_SA(1, 1), a1 + hstep, voffA);
            PG8_WAIT_L(8); PG8_BAR; PG8_WAIT_L(0); PG8_MMA(0, 0, At, B0); PG8_BAR; PG8_SCHED;
            PG8_LDB(B1, 0, 1); PG8_STAGE(PG8_SB(0, 0), b2, voffB);
            PG8_BAR; PG8_WAIT_L(0); PG8_MMA(0, 1, At, B1); PG8_BAR;
            PG8_LDA(At, 0, 1); PG8_STAGE(PG8_SA(0, 0), a2, voffA);
            PG8_BAR; PG8_WAIT_L(0); PG8_MMA(1, 0, At, B0); PG8_BAR; PG8_SCHED;
            PG8_STAGE(PG8_SB(0, 1), b2 + hstep, voffB);
            PG8_WAIT_V(6); PG8_BAR; PG8_MMA(1, 1, At, B1); PG8_BAR;
            PG8_LDB(B0, 1, 0); PG8_SCHED; PG8_LDA(At, 1, 0); PG8_STAGE(PG8_SA(0, 1), a2 + hstep, voffA);
            PG8_WAIT_L(8); PG8_BAR; PG8_WAIT_L(0); PG8_MMA(0, 0, At, B0); PG8_BAR; PG8_SCHED;
            PG8_LDB(B1, 1, 1); PG8_STAGE(PG8_SB(1, 0), b3, voffB);
            PG8_BAR; PG8_WAIT_L(0); PG8_MMA(0, 1, At, B1); PG8_BAR;
            PG8_LDA(At, 1, 1); PG8_STAGE(PG8_SA(1, 0), a3, voffA);
            PG8_BAR; PG8_WAIT_L(0); PG8_MMA(1, 0, At, B0); PG8_BAR; PG8_SCHED;
            PG8_STAGE(PG8_SB(1, 1), b3 + hstep, voffB);
            PG8_WAIT_V(6); PG8_BAR; PG8_MMA(1, 1, At, B1); PG8_BAR;
            }
        }
        if constexpr (ALIGN_EPI) { if (wr == 0) PG8_BAR; }
        if constexpr (!Epi::AFTER_DRAIN) { E(acc, cur, wr, wc, fr, fq); S.done(cur); }
        if (!has_next) break;
#pragma unroll
        for (int a = 0; a < 2; ++a)
#pragma unroll
            for (int b = 0; b < 2; ++b)
#pragma unroll
                for (int m = 0; m < 4; ++m)
#pragma unroll
                    for (int n = 0; n < 2; ++n) acc[a][b][m][n] = (f32x4){0.f, 0.f, 0.f, 0.f};
        cur = nxt; cA = nA; cB = nB; ++ui;
        if constexpr (ALIGN_EPI) { if (wr == 1) PG8_BAR; }
    }
    PG8_WAIT_V(0);
    if constexpr (!ALIGN_EPI) { if (wr == 0) PG8_BAR; }
    PG8_BAR;
    if constexpr (Epi::AFTER_DRAIN) { E.fused(acc, cur, wr, wc, fr, fq, lds, wid, lane); S.done(cur); }
#undef PG8_SA
#undef PG8_SB
#undef PG8_STAGE
#undef PG8_LDA
#undef PG8_LDB
#undef PG8_MMA
#undef PG8_WAIT_V
#undef PG8_WAIT_L
#undef PG8_BAR
#undef PG8_SCHED
}
}
constexpr int MB = 2, SEQL = 16384, DM = 1024, MTOK = MB * SEQL, FFH = 2816, NHEAD = 16;
constexpr size_t MiB = 1u << 20;
constexpr size_t WS_PART = 0;
constexpr size_t WS_RSTD = 2 * MiB;
constexpr size_t WS_WHIN = 4 * MiB;
constexpr size_t WS_WHOUT = 10 * MiB;
constexpr size_t WS_WQKV = 12 * MiB;
constexpr size_t WS_WO = 18 * MiB;
constexpr size_t WS_WGU0 = 20 * MiB, WS_WGU1 = 31 * MiB;
constexpr size_t WS_WD0 = 42 * MiB, WS_WD1 = 48 * MiB;
constexpr size_t WS_WFO = 54 * MiB;
constexpr size_t WS_HF = 56 * MiB;
constexpr size_t WS_XN = 64 * MiB;
constexpr size_t WS_U = 128 * MiB;
constexpr size_t WS_Z = 192 * MiB;
constexpr size_t WS_VT = WS_Z + 128 * MiB;
constexpr size_t WS_UT = 384 * MiB;
constexpr size_t WS_GT = 448 * MiB;
constexpr size_t WS_END = 512 * MiB;
constexpr int LDS_BYTES = 147456;
constexpr int NPHASE = 14;

#define LAS __attribute__((address_space(3)))
typedef unsigned short bf16;
typedef unsigned v4u __attribute__((ext_vector_type(4)));
typedef unsigned v2u __attribute__((ext_vector_type(2)));
typedef float f32x4 __attribute__((ext_vector_type(4)));
typedef short bf16x8 __attribute__((ext_vector_type(8)));
typedef short s16x4 __attribute__((ext_vector_type(4)));
__device__ __forceinline__ unsigned f2bf(float f) { unsigned u = __builtin_bit_cast(unsigned, f); return (u + 0x7fffu + ((u >> 16) & 1u)) >> 16; }
__device__ __forceinline__ unsigned pk2(float lo, float hi) { unsigned r; asm("v_cvt_pk_bf16_f32 %0, %1, %2" : "=v"(r) : "v"(lo), "v"(hi)); return r; }
__device__ __forceinline__ float bflo(unsigned w) { return __uint_as_float(w << 16); }
__device__ __forceinline__ float bfhi(unsigned w) { return __uint_as_float(w & 0xffff0000u); }
__device__ __forceinline__ float bf1(bf16 h) { return __uint_as_float((unsigned)h << 16); }
#define LDS_WAIT() asm volatile("s_waitcnt lgkmcnt(0)" ::: "memory")

struct Args {
    const float* in[28]; float* out; unsigned char* ws; int ph_lo, ph_hi;
};
struct Frame { LAS unsigned char* lds; int tid, lane, wave, G, bid; };

__device__ __forceinline__ float wave_sum(float v) {
#pragma unroll
    for (int o = 1; o < 64; o <<= 1) v += __shfl_xor(v, o);
    return v;
}
__device__ __forceinline__ void transpose_item(const float* W, int K, int N, const float* gain, bf16* WT, int out_row0, LAS float* scr, int k0, int n0, int lane) {
    f32x4 v[16];
#pragma unroll
    for (int i = 0; i < 16; ++i) { const int kk = 4 * i + (lane >> 4); v[i] = *(const f32x4*)(W + (size_t)(k0 + kk) * N + n0 + 4 * (lane & 15)); }
#pragma unroll
    for (int i = 0; i < 16; ++i) { const int kk = 4 * i + (lane >> 4); const float g = gain ? gain[k0 + kk] : 1.0f; LAS float* d = scr + kk * 65 + 4 * (lane & 15);
        d[0] = v[i].x * g; d[1] = v[i].y * g; d[2] = v[i].z * g; d[3] = v[i].w * g; }
    LDS_WAIT(); asm volatile("" ::: "memory");
    const int c = lane & 7;
#pragma unroll
    for (int j = 0; j < 8; ++j) { const int n = (lane >> 3) + 8 * j; const LAS float* s = scr + (8 * c) * 65 + n;
        v4u o; o.x = pk2(s[0 * 65], s[1 * 65]); o.y = pk2(s[2 * 65], s[3 * 65]); o.z = pk2(s[4 * 65], s[5 * 65]); o.w = pk2(s[6 * 65], s[7 * 65]);
        *(v4u*)(WT + (size_t)(out_row0 + n) * K + k0 + 8 * c) = o; }
    LDS_WAIT(); asm volatile("" ::: "memory");
}
__device__ __forceinline__ void transpose_matrix(const Frame& F, const float* W, int K, int N, const float* gain, bf16* WT, int kind, int& base) {
    LAS float* scr = (LAS float*)(F.lds + F.wave * 17408);
    const int nblk = N / 64, nitems = (K / 64) * nblk, gw = F.bid * 8 + F.wave, NGW = F.G * 8;
    int first = (gw - (base % NGW) + NGW) % NGW;
    for (int it = first; it < nitems; it += NGW) { const int kb = it / nblk, nb = it % nblk, n0 = nb * 64;
        int r0 = n0; if (kind) r0 = 256 * (n0 / 128) + (n0 % 128) + (kind == 2 ? 128 : 0);
        transpose_item(W, K, N, gain, WT, r0, scr, kb * 64, n0, F.lane); }
    base += nitems;
}
__device__ __forceinline__ void norm_rows4_to_bf16(const float* xrow, bf16* orow, int lane) {
    f32x4 v[4][4]; float s[4];
#pragma unroll
    for (int r = 0; r < 4; ++r) { const f32x4* xr = (const f32x4*)(xrow + (size_t)r * DM) + lane; s[r] = 0.f;
#pragma unroll
        for (int j = 0; j < 4; ++j) v[r][j] = xr[64 * j]; }
#pragma unroll
    for (int r = 0; r < 4; ++r) {
#pragma unroll
        for (int j = 0; j < 4; ++j) s[r] += (v[r][j].x * v[r][j].x + v[r][j].y * v[r][j].y) + (v[r][j].z * v[r][j].z + v[r][j].w * v[r][j].w); }
#pragma unroll
    for (int o = 1; o < 64; o <<= 1) {
#pragma unroll
        for (int r = 0; r < 4; ++r) s[r] += __shfl_xor(s[r], o); }
#pragma unroll
    for (int r = 0; r < 4; ++r) { const float rstd = __builtin_amdgcn_rsqf(s[r] * (1.0f / DM) + 1e-6f);
        unsigned long long* o8 = (unsigned long long*)(orow + (size_t)r * DM) + lane;
#pragma unroll
        for (int j = 0; j < 4; ++j) o8[64 * j] = (unsigned long long)pk2(v[r][j].x * rstd, v[r][j].y * rstd) | ((unsigned long long)pk2(v[r][j].z * rstd, v[r][j].w * rstd) << 32); }
}
__device__ __forceinline__ float rdl(float v, int l) { return __int_as_float(__builtin_amdgcn_readlane(__float_as_int(v), l)); }
__device__ __forceinline__ void filter_mlp(const Frame& F, const float* w1, const float* b1, const float* w2, const float* b2, const float* w3, const float* b3, const float* freq, bf16* HF) {
    const int gw = F.bid * 8 + F.wave, NGW = F.G * 8, lane = F.lane;
    const float fr = freq[lane], bb1 = b1[lane], bb2 = b2[lane], bb3 = b3[lane];
    const float band = 1e-4f + (float)(lane & 15) * ((15.0f - 1e-4f) / 15.0f);
    float W1r[33], W2r[64], W3r[64];
#pragma unroll
    for (int i = 0; i < 33; ++i) W1r[i] = w1[i * 64 + lane];
#pragma unroll
    for (int k = 0; k < 64; ++k) { W2r[k] = w2[k * 64 + lane]; W3r[k] = w3[k * 64 + lane]; }
    for (int pos = gw; pos < SEQL; pos += NGW) {
        const float t = (float)pos * (1.0f / (float)(SEQL - 1));
        const float w = 6.283185307179586f * (float)pos / (float)SEQL;
        const float arg = band * w; const float c = cosf(arg), s = -sinf(arg);
        float a = bb1 + t * W1r[0];
#pragma unroll
        for (int i = 0; i < 16; ++i) a += rdl(c, i) * W1r[1 + i] + rdl(s, i) * W1r[17 + i];
        float h = sinf(fr * a);
        a = bb2;
#pragma unroll
        for (int k = 0; k < 64; ++k) a += rdl(h, k) * W2r[k];
        h = sinf(fr * a);
        a = bb3;
#pragma unroll
        for (int k = 0; k < 64; ++k) a += rdl(h, k) * W3r[k];
        h = sinf(fr * a);
        HF[(size_t)pos * 128 + lane] = (bf16)f2bf(h); HF[(size_t)pos * 128 + 64 + lane] = 0;
    }
}
__device__ __forceinline__ constexpr int brev5(int x) { return ((x & 1) << 4) | ((x & 2) << 2) | (x & 4) | ((x & 8) >> 2) | ((x & 16) >> 4); }
#define TWR_LIST 1.000000000f, 0.995184727f, 0.980785280f, 0.956940336f, 0.923879533f, 0.881921264f, 0.831469612f, 0.773010453f, 0.707106781f, 0.634393284f, 0.555570233f, 0.471396737f, 0.382683432f, 0.290284677f, 0.195090322f, 0.098017140f, 0.000000000f, -0.098017140f, -0.195090322f, -0.290284677f, -0.382683432f, -0.471396737f, -0.555570233f, -0.634393284f, -0.707106781f, -0.773010453f, -0.831469612f, -0.881921264f, -0.923879533f, -0.956940336f, -0.980785280f, -0.995184727f
#define TWI_LIST -0.000000000f, -0.098017140f, -0.195090322f, -0.290284677f, -0.382683432f, -0.471396737f, -0.555570233f, -0.634393284f, -0.707106781f, -0.773010453f, -0.831469612f, -0.881921264f, -0.923879533f, -0.956940336f, -0.980785280f, -0.995184727f, -1.000000000f, -0.995184727f, -0.980785280f, -0.956940336f, -0.923879533f, -0.881921264f, -0.831469612f, -0.773010453f, -0.707106781f, -0.634393284f, -0.555570233f, -0.471396737f, -0.382683432f, -0.290284677f, -0.195090322f, -0.098017140f
typedef float f2 __attribute__((ext_vector_type(2)));
__device__ __forceinline__ f2 cmulw(f2 a, float wr, float wi) { const f2 s = __builtin_shufflevector(a, a, 1, 0); return s * (f2){-wi, wi} + a * (f2){wr, wr}; }
__device__ __forceinline__ f2 cmulc(f2 a, float wr, float wi) { const f2 s = __builtin_shufflevector(a, a, 1, 0); return s * (f2){wi, -wi} + a * (f2){wr, wr}; }
__device__ __forceinline__ f2 cmulr(f2 a, f2 c) { f2 t, r;
    asm("v_pk_mul_f32 %0, %1, %2 op_sel_hi:[1,0]" : "=v"(t) : "v"(a), "v"(c));
    asm("v_pk_fma_f32 %0, %1, %2, %3 op_sel:[1,1,0] op_sel_hi:[0,1,1] neg_lo:[0,1,0]" : "=v"(r) : "v"(a), "v"(c), "v"(t)); return r; }
__device__ __forceinline__ f2 cmulrc(f2 a, f2 c) { f2 t, r;
    asm("v_pk_mul_f32 %0, %1, %2 op_sel_hi:[1,0]" : "=v"(t) : "v"(a), "v"(c));
    asm("v_pk_fma_f32 %0, %1, %2, %3 op_sel:[1,1,0] op_sel_hi:[0,1,1] neg_hi:[0,1,0]" : "=v"(r) : "v"(a), "v"(c), "v"(t)); return r; }
__device__ __forceinline__ void fft32(f2 (&x)[32]) {
    constexpr float TWR[32] = {TWR_LIST}; constexpr float TWI[32] = {TWI_LIST};
#pragma unroll
    for (int h = 16; h >= 1; h >>= 1) {
#pragma unroll
        for (int i0 = 0; i0 < 32; i0 += 2 * h) {
#pragma unroll
            for (int j = 0; j < h; ++j) {
                const int i = i0 + j, k = i + h, m = j * (32 / h);
                const f2 a = x[i], b = x[k], d = a - b;
                x[i] = a + b;
                if (m == 0) x[k] = d;
                else if (m == 16) x[k] = (f2){d.y, -d.x};
                else x[k] = cmulw(d, TWR[m], TWI[m]);
            }
        }
    }
}
__device__ __forceinline__ void ifft32(f2 (&x)[32]) {
    constexpr float TWR[32] = {TWR_LIST}; constexpr float TWI[32] = {TWI_LIST};
#pragma unroll
    for (int h = 1; h <= 16; h <<= 1) {
#pragma unroll
        for (int i0 = 0; i0 < 32; i0 += 2 * h) {
#pragma unroll
            for (int j = 0; j < h; ++j) {
                const int i = i0 + j, k = i + h, m = j * (32 / h);
                const f2 a = x[i], y = x[k];
                f2 b;
                if (m == 0) b = y;
                else if (m == 16) b = (f2){-y.y, y.x};
                else b = cmulc(y, TWR[m], TWI[m]);
                x[i] = a + b; x[k] = a - b;
            }
        }
    }
}
constexpr int XP = 528;
constexpr int FFT_CT = 32 * XP * 8;
template <bool CONJ> __device__ __forceinline__ void twiddle32(f2 (&x)[32], float wr, float wi) {
    asm volatile("" : "+v"(wr), "+v"(wi));
    f2 c = (f2){wr, CONJ ? -wi : wi}; const f2 w = c;
#pragma unroll
    for (int k = 1; k < 32; ++k) { const int p = brev5(k); x[p] = cmulr(x[p], c); if (k < 31) c = cmulr(c, w); }
}
template <bool CONJ> __device__ __forceinline__ void twiddleN(f2 (&x)[32], float wr, float wi) {
    float sr = 0.995184727f, si = CONJ ? 0.098017140f : -0.098017140f;
    asm volatile("" : "+v"(wr), "+v"(wi), "+v"(sr), "+v"(si));
    f2 e = (f2){wr, CONJ ? -wi : wi}; const f2 st = (f2){sr, si};
#pragma unroll
    for (int n1 = 0; n1 < 32; ++n1) { x[n1] = cmulr(x[n1], e); if (n1 < 31) e = cmulr(e, st); }
}
__device__ __forceinline__ float lx1(float v) { return __int_as_float(__builtin_amdgcn_update_dpp(0, __float_as_int(v), 0xB1, 0xF, 0xF, true)); }
__device__ __forceinline__ float lx2(float v) { return __int_as_float(__builtin_amdgcn_update_dpp(0, __float_as_int(v), 0x4E, 0xF, 0xF, true)); }
__device__ __forceinline__ float lx4(float v) { return __int_as_float(__builtin_amdgcn_ds_swizzle(__float_as_int(v), 0x101F)); }
__device__ __forceinline__ float lx8(float v) { return __int_as_float(__builtin_amdgcn_update_dpp(0, __float_as_int(v), 0x128, 0xF, 0xF, true)); }
#define LBAR() do { asm volatile("s_waitcnt lgkmcnt(0)" ::: "memory"); __builtin_amdgcn_s_barrier(); asm volatile("" ::: "memory"); } while (0)
struct M2C { float w2r, w2i, t8r, t8i, t4r, t4i, t2r, t2i, s8, s4, s2, s1; };
__device__ __forceinline__ M2C m2c_load(LAS const M2C* MC) { M2C c; LAS const float* q = (LAS const float*)MC; c.w2r = q[0]; c.w2i = q[1]; c.t8r = q[2]; c.t8i = q[3]; c.t4r = q[4]; c.t4i = q[5]; c.t2r = q[6]; c.t2i = q[7]; c.s8 = q[8]; c.s4 = q[9]; c.s2 = q[10]; c.s1 = q[11]; return c; }
__device__ __forceinline__ void fft_forward(f2 (&x)[32], LAS f2* X, int t, LAS const float* W1, LAS const M2C* MC) {
    fft32(x);
    { const float wr = W1[0], wi = W1[1]; twiddle32<false>(x, wr * wr - wi * wi, 2.f * wr * wi); }
    LAS f2* wp = X + t; LAS const f2* rp = X + (t >> 4) * XP + (t & 15); LAS f2* wp1 = wp + 16 * XP; LAS const f2* rp1 = rp + 256;
    asm volatile("" : "+v"(wp), "+v"(rp), "+v"(wp1), "+v"(rp1));
#pragma unroll
    for (int k = 0; k < 16; ++k) { wp[k * XP] = x[brev5(k)]; wp1[k * XP] = x[brev5(k + 16)]; }
    LBAR();
#pragma unroll
    for (int m = 0; m < 16; ++m) { x[m] = rp[16 * m]; x[m + 16] = rp1[16 * m]; }
    LBAR();
    fft32(x);
    const M2C c = m2c_load(MC); const f2 t8 = (f2){c.t8r, c.t8i}, t4 = (f2){c.t4r, c.t4i}, t2 = (f2){c.t2r, c.t2i};
    twiddle32<false>(x, c.w2r, c.w2i);
#pragma unroll
    for (int p = 0; p < 32; ++p) {
        f2 v = x[p], pr;
        pr = (f2){lx8(v.x), lx8(v.y)}; v = cmulr(pr + v * c.s8, t8);
        pr = (f2){lx4(v.x), lx4(v.y)}; v = cmulr(pr + v * c.s4, t4);
        pr = (f2){lx2(v.x), lx2(v.y)}; v = cmulr(pr + v * c.s2, t2);
        pr = (f2){lx1(v.x), lx1(v.y)}; x[p] = pr + v * c.s1;
    }
}
__device__ __forceinline__ void fft_inverse(f2 (&x)[32], LAS f2* X, int t, LAS const float* W1, LAS const M2C* MC) {
    const M2C c = m2c_load(MC); const f2 t8 = (f2){c.t8r, c.t8i}, t4 = (f2){c.t4r, c.t4i}, t2 = (f2){c.t2r, c.t2i};
#pragma unroll
    for (int p = 0; p < 32; ++p) {
        f2 v = x[p], pr;
        pr = (f2){lx1(v.x), lx1(v.y)}; v = cmulrc(pr + v * c.s1, t2);
        pr = (f2){lx2(v.x), lx2(v.y)}; v = cmulrc(pr + v * c.s2, t4);
        pr = (f2){lx4(v.x), lx4(v.y)}; v = cmulrc(pr + v * c.s4, t8);
        pr = (f2){lx8(v.x), lx8(v.y)}; x[p] = pr + v * c.s8;
    }
    twiddle32<true>(x, c.w2r, c.w2i);
    ifft32(x);
    LAS f2* wp = X + (t >> 4) * XP + (t & 15); LAS const f2* rp = X + t; LAS f2* wp1 = wp + 256; LAS const f2* rp1 = rp + 16 * XP;
    asm volatile("" : "+v"(wp), "+v"(rp), "+v"(wp1), "+v"(rp1));
#pragma unroll
    for (int m = 0; m < 16; ++m) { wp[16 * m] = x[m]; wp1[16 * m] = x[m + 16]; }
    LBAR();
#pragma unroll
    for (int k = 0; k < 16; ++k) { x[brev5(k)] = rp[k * XP]; x[brev5(k + 16)] = rp1[k * XP]; }
    LBAR();
    { const float wr = W1[0], wi = W1[1]; twiddle32<true>(x, wr * wr - wi * wi, 2.f * wr * wi); }
    ifft32(x);
}
__device__ __forceinline__ void conv8(const bf16* row, int p0, float c0, float c1, float c2, float cb, float (&o)[8]) {
    const v4u w = *(const v4u*)(row + p0);
    float x[10];
    x[0] = bf1(row[p0 > 0 ? p0 - 1 : 0]) * (p0 > 0 ? 1.f : 0.f); x[9] = bf1(row[p0 + 8 < SEQL ? p0 + 8 : SEQL - 1]) * (p0 + 8 < SEQL ? 1.f : 0.f);
    x[1] = bflo(w.x); x[2] = bfhi(w.x); x[3] = bflo(w.y); x[4] = bfhi(w.y); x[5] = bflo(w.z); x[6] = bfhi(w.z); x[7] = bflo(w.w); x[8] = bfhi(w.w);
#pragma unroll
    for (int e = 0; e < 8; ++e) o[e] = c0 * x[e] + c1 * x[e + 1] + c2 * x[e + 2] + cb;
}
template <int VAR> __device__ __forceinline__ void hyena_conv_phase(const Frame& F, const bf16* ZT, const bf16* GT, const float* conv_w, const float* conv_b, const float* skip, float* gscr, float* zscr, bf16* UT) {
    LAS float* X = (LAS float*)F.lds; LAS f2* X2 = (LAS f2*)F.lds;
    const int t0 = F.tid;
    LAS float* W1 = (LAS float*)(F.lds + FFT_CT) + 2 * t0;
    LAS M2C* MCT = (LAS M2C*)(F.lds + FFT_CT + 4096);
    LAS float* RED = (LAS float*)(F.lds + FFT_CT + 4096 + 16 * 48);
    { float s, c; sincospif(-2.0f * (float)t0 / 32768.0f, &s, &c); W1[0] = c; W1[1] = s;
      if (t0 < 16) { const int m2 = t0; M2C k; sincospif(-2.0f * (float)m2 / 512.0f, &s, &c); k.w2r = c; k.w2i = s;
          sincospif(-2.0f * (float)(m2 & 7) / 16.0f, &s, &c); k.t8r = (m2 & 8) ? c : 1.f; k.t8i = (m2 & 8) ? s : 0.f; k.s8 = (m2 & 8) ? -1.f : 1.f;
          sincospif(-2.0f * (float)(m2 & 3) / 8.0f, &s, &c); k.t4r = (m2 & 4) ? c : 1.f; k.t4i = (m2 & 4) ? s : 0.f; k.s4 = (m2 & 4) ? -1.f : 1.f;
          k.t2r = (m2 & 2) ? ((m2 & 1) ? 0.f : 1.f) : 1.f; k.t2i = (m2 & 2) ? ((m2 & 1) ? -1.f : 0.f) : 0.f; k.s2 = (m2 & 2) ? -1.f : 1.f;
          k.s1 = (m2 & 1) ? -1.f : 1.f; LAS float* q = (LAS float*)(MCT + m2); q[0] = k.w2r; q[1] = k.w2i; q[2] = k.t8r; q[3] = k.t8i; q[4] = k.t4r; q[5] = k.t4i; q[6] = k.t2r; q[7] = k.t2i; q[8] = k.s8; q[9] = k.s4; q[10] = k.s2; q[11] = k.s1; } }
    __syncthreads();
    LAS const M2C* MC = MCT + (t0 & 15);
    typedef __attribute__((address_space(1))) unsigned gu32; typedef __attribute__((address_space(1))) v4u gv4;
    (void)gscr;
    gu32* zs = (gu32*)((unsigned*)zscr + (size_t)F.bid * 32768);
    for (int c = F.bid; c < DM; c += F.G) {
        const bf16* rx0 = ZT + (size_t)c * MTOK; const bf16* rx1 = ZT + (size_t)(DM + c) * MTOK; const bf16* rv = ZT + (size_t)(2 * DM + c) * MTOK;
        const float a0 = conv_w[c], a1 = conv_w[3072 + c], a2 = conv_w[6144 + c], ab = conv_b[c];
        const float b0 = conv_w[DM + c], b1 = conv_w[3072 + DM + c], b2 = conv_w[6144 + DM + c], bb = conv_b[DM + c];
        const float v0 = conv_w[2 * DM + c], v1 = conv_w[3072 + 2 * DM + c], v2 = conv_w[6144 + 2 * DM + c], vb = conv_b[2 * DM + c];
        const bf16* gf = GT + (size_t)c * SEQL; const bf16* gb = GT + (size_t)(DM + c) * SEQL;
        int t = t0; asm volatile("" : "+v"(t));
        float gsc = 1.f; const float skn = skip[c] * (1.0f / 32768.0f);
#pragma unroll
        for (int qi = 0; qi < 8; ++qi) { const int q = t + 512 * qi; const int b = qi >> 2, p0 = (q & 2047) * 8; float cv[8], cx[8];
            conv8(rv + b * SEQL, p0, v0, v1, v2, vb, cv); conv8(rx1 + b * SEQL, p0, b0, b1, b2, bb, cx);
            f32x4 o0, o1;
#pragma unroll
            for (int e = 0; e < 4; ++e) { o0[e] = cv[e] * cx[e]; o1[e] = cv[4 + e] * cx[4 + e]; }
            *(LAS f32x4*)(X + b * SEQL + p0) = o0; *(LAS f32x4*)(X + b * SEQL + p0 + 4) = o1; }
        __syncthreads();
        { gv4* pz = (gv4*)zs + t; LAS const float* x0p = X + t; LAS const float* x1p = X + SEQL + t; asm volatile("" : "+v"(x0p), "+v"(x1p), "+v"(pz));
#pragma unroll
          for (int g = 0; g < 8; ++g) { v4u w; w.x = pk2(x0p[512 * (4 * g)], x1p[512 * (4 * g)]); w.y = pk2(x0p[512 * (4 * g + 1)], x1p[512 * (4 * g + 1)]); w.z = pk2(x0p[512 * (4 * g + 2)], x1p[512 * (4 * g + 2)]); w.w = pk2(x0p[512 * (4 * g + 3)], x1p[512 * (4 * g + 3)]);
              *pz = w; pz += 512; asm volatile("" : "+v"(pz)); } }
        __syncthreads();
        unsigned dpk[16]; unsigned gpre[32];
#pragma unroll 1
        for (int jit = 0; jit < 4; ++jit) {
            const int job = (jit == 1) ? 2 : (jit == 2) ? 1 : jit;
            const int half = job & 1;
            f2 x[32];
            int t = t0; asm volatile("" : "+v"(t));
            if (job == 1) {
#pragma unroll
                for (int n1 = 0; n1 < 32; n1 += 2) { const unsigned w = dpk[n1 >> 1]; x[n1] = (f2){bflo(w), 0.f}; x[n1 + 1] = (f2){bfhi(w), 0.f}; }
            } else if (job == 0) { const bf16* pf = gf + t; const bf16* pb = gb + (SEQL - t); float asum = 0.f; float dprev = 0.f;
#pragma unroll
                for (int n1 = 0; n1 < 32; ++n1) { const float f = bf1(*pf), bk = (n1 == 0 && t == 0) ? 0.f : bf1(*pb); pf += 512; pb -= 512; asm volatile("" : "+v"(pf), "+v"(pb));
                    x[n1] = (f2){f + bk, 0.f}; asum += fabsf(f) + fabsf(bk);
                    if (n1 & 1) dpk[n1 >> 1] = pk2(dprev, f - bk); else dprev = f - bk; }
                {
                    float v = asum; v += lx1(v); v += lx2(v); v += lx4(v); v += lx8(v);
                    v += __int_as_float(__builtin_amdgcn_ds_swizzle(__float_as_int(v), 0x401F));
                    const float w64 = rdl(v, 0) + rdl(v, 32);
                    if (F.lane == 0) RED[F.wave] = w64;
                    __syncthreads();
                    const float tot = ((RED[0] + RED[1]) + (RED[2] + RED[3])) + ((RED[4] + RED[5]) + (RED[6] + RED[7]));
                    __syncthreads();
                    gsc = 1.0f / (tot * 32768.0f); }
            } else { const gv4* pz = (const gv4*)zs + t;
#pragma unroll
                for (int g = 0; g < 8; ++g) { const v4u w = *pz; pz += 512; asm volatile("" : "+v"(pz));
                    x[4 * g] = (f2){bflo(w.x), bfhi(w.x)}; x[4 * g + 1] = (f2){bflo(w.y), bfhi(w.y)}; x[4 * g + 2] = (f2){bflo(w.z), bfhi(w.z)}; x[4 * g + 3] = (f2){bflo(w.w), bfhi(w.w)}; }
            }
            if (half) twiddleN<false>(x, W1[0], W1[1]);
            if (VAR != 1) fft_forward(x, X2, t, W1, MC);
            if (job < 2) {
#pragma unroll
                for (int p = 0; p < 32; ++p) gpre[p] = pk2(x[p].x * gsc + skn, x[p].y * gsc);
            } else {
#pragma unroll
                for (int p = 0; p < 32; ++p) { const unsigned w = gpre[p]; x[p] = cmulr(x[p], (f2){bflo(w), bfhi(w)}); }
                gv4* py = (gv4*)(zs + 16384) + t;
                if (VAR != 1) fft_inverse(x, X2, t, W1, MC);
                if (half == 0) {
#pragma unroll
                    for (int g = 0; g < 8; ++g) { v4u w; w.x = pk2(x[4 * g].x, x[4 * g].y); w.y = pk2(x[4 * g + 1].x, x[4 * g + 1].y); w.z = pk2(x[4 * g + 2].x, x[4 * g + 2].y); w.w = pk2(x[4 * g + 3].x, x[4 * g + 3].y);
                        *py = w; py += 512; asm volatile("" : "+v"(py)); }
                } else {
                    twiddleN<true>(x, W1[0], W1[1]);
                    LAS float* x0p = X + t; LAS float* x1p = X + SEQL + t; asm volatile("" : "+v"(x0p), "+v"(x1p));
#pragma unroll
                    for (int g = 0; g < 8; ++g) { const v4u w = *py; py += 512; asm volatile("" : "+v"(py));
                        x0p[512 * (4 * g)] = x[4 * g].x + bflo(w.x); x1p[512 * (4 * g)] = x[4 * g].y + bfhi(w.x); x0p[512 * (4 * g + 1)] = x[4 * g + 1].x + bflo(w.y); x1p[512 * (4 * g + 1)] = x[4 * g + 1].y + bfhi(w.y);
                        x0p[512 * (4 * g + 2)] = x[4 * g + 2].x + bflo(w.z); x1p[512 * (4 * g + 2)] = x[4 * g + 2].y + bfhi(w.z); x0p[512 * (4 * g + 3)] = x[4 * g + 3].x + bflo(w.w); x1p[512 * (4 * g + 3)] = x[4 * g + 3].y + bfhi(w.w); }
                }
            }
        }
        __syncthreads();
        int te = t0; asm volatile("" : "+v"(te));
#pragma unroll
        for (int qi = 0; qi < 8; ++qi) { const int q = te + 512 * qi; const int b = qi >> 2, p0 = (q & 2047) * 8; float c0[8];
            conv8(rx0 + b * SEQL, p0, a0, a1, a2, ab, c0);
            const f32x4 y0 = *(LAS f32x4*)(X + b * SEQL + p0), y1 = *(LAS f32x4*)(X + b * SEQL + p0 + 4);
            float u[8];
#pragma unroll
            for (int e = 0; e < 4; ++e) { u[e] = y0[e] * c0[e]; u[4 + e] = y1[e] * c0[4 + e]; }
            v4u o; o.x = pk2(u[0], u[1]); o.y = pk2(u[2], u[3]); o.z = pk2(u[4], u[5]); o.w = pk2(u[6], u[7]);
            *(v4u*)(UT + (size_t)c * MTOK + b * SEQL + p0) = o; }
        __syncthreads();
    }
}
__device__ __forceinline__ void transpose_ut_phase(const Frame& F, const bf16* UT, bf16* U) {
    LAS unsigned short* T = (LAS unsigned short*)F.lds;
    const int t = F.tid; constexpr int NT = 16 * 128;
    const int ch0 = t >> 5, seg = t & 31;
    v4u cur[4];
    if (F.bid < NT) { const int c0 = (F.bid & 15) * 64, m0 = (F.bid >> 4) * 256;
#pragma unroll
        for (int i = 0; i < 4; ++i) cur[i] = *(const v4u*)(UT + (size_t)(c0 + ch0 + 16 * i) * MTOK + m0 + seg * 8); }
    for (int tile = F.bid; tile < NT; tile += F.G) { const int c0 = (tile & 15) * 64, m0 = (tile >> 4) * 256;
        const int nt = tile + F.G; v4u nxt[4];
        if (nt < NT) { const int c1 = (nt & 15) * 64, m1 = (nt >> 4) * 256;
#pragma unroll
            for (int i = 0; i < 4; ++i) nxt[i] = *(const v4u*)(UT + (size_t)(c1 + ch0 + 16 * i) * MTOK + m1 + seg * 8); }
#pragma unroll
        for (int i = 0; i < 4; ++i) { LAS unsigned* d = (LAS unsigned*)(T + (ch0 + 16 * i) * 258 + seg * 8); d[0] = cur[i].x; d[1] = cur[i].y; d[2] = cur[i].z; d[3] = cur[i].w; }
        asm volatile("s_waitcnt lgkmcnt(0)" ::: "memory"); __builtin_amdgcn_s_barrier(); asm volatile("" ::: "memory");
#pragma unroll
        for (int i = 0; i < 4; ++i) { const int cg8 = t & 7, j = (t >> 3) + 64 * i;
            unsigned short v[8];
#pragma unroll
            for (int e = 0; e < 8; ++e) v[e] = T[(8 * cg8 + e) * 258 + j];
            v4u o; o.x = v[0] | ((unsigned)v[1] << 16); o.y = v[2] | ((unsigned)v[3] << 16); o.z = v[4] | ((unsigned)v[5] << 16); o.w = v[6] | ((unsigned)v[7] << 16);
            *(v4u*)(U + (size_t)(m0 + j) * DM + c0 + 8 * cg8) = o; }
        asm volatile("s_waitcnt lgkmcnt(0)" ::: "memory"); __builtin_amdgcn_s_barrier(); asm volatile("" ::: "memory");
        if (nt < NT) {
#pragma unroll
            for (int i = 0; i < 4; ++i) cur[i] = nxt[i]; }
    }
}
__device__ __forceinline__ void na_phase(const Frame& F, const bf16* QH, const bf16* VB, const float* rpb, bf16* U) {
    const bf16* KH = QH + (size_t)16 * MTOK * 64;
    LAS float* RP = (LAS float*)F.lds;
    for (int i = F.tid; i < 16 * 465; i += 512) RP[i] = rpb[i];
    __syncthreads();
    const int lane = F.lane, n = lane & 15, q4 = lane >> 4;
    const int vcu = (F.G % 8 == 0) ? (F.bid % 8) * (F.G / 8) + F.bid / 8 : F.bid;
    for (int br = vcu; br < MB * 256; br += F.G) {
        const int b = br >> 8, r = br & 255;
        const int rs = min(max(r - 4, 0), 248);
#pragma unroll 1
        for (int it = 0; it < 8; ++it) {
            const int hj = it * 8 + F.wave, h = hj >> 2, j = hj & 3;
            const int c0 = (j == 0) ? 0 : (j == 1) ? 8 : (j == 2) ? 24 : 32;
            const int qcol = 16 * j + n, cs = min(max(qcol - 8, 0), 48);
            const size_t tokq = (size_t)b * SEQL + r * 64 + qcol;
            bf16x8 qf[2];
#pragma unroll
            for (int ks = 0; ks < 2; ++ks) qf[ks] = *(const bf16x8*)(QH + (((size_t)h * 2 + ks) * MTOK + tokq) * 32 + q4 * 8);
            f32x4 acc[16];
#pragma unroll
            for (int blk = 0; blk < 16; ++blk) { const int i = blk >> 1, hf = blk & 1;
                const size_t tokk = (size_t)b * SEQL + (rs + i) * 64 + c0 + 8 * (n >> 2) + 4 * hf + (n & 3);
                const bf16* kp = KH + ((size_t)h * 2 * MTOK + tokk) * 32 + q4 * 8; const bf16x8 k0 = *(const bf16x8*)kp, k1 = *(const bf16x8*)(kp + (size_t)MTOK * 32);
                f32x4 a = (f32x4){0.f, 0.f, 0.f, 0.f};
                a = __builtin_amdgcn_mfma_f32_16x16x32_bf16(k0, qf[0], a, 0, 0, 0);
                a = __builtin_amdgcn_mfma_f32_16x16x32_bf16(k1, qf[1], a, 0, 0, 0);
                acc[blk] = a; }
            float mx = -3.0e38f;
            int cofs[8]; bool okk[8];
#pragma unroll
            for (int k8 = 0; k8 < 8; ++k8) { const int kc = c0 + 8 * q4 + 4 * (k8 >> 2) + (k8 & 3); okk[k8] = (kc >= cs) && (kc < cs + 16); cofs[k8] = min(max(kc - qcol + 15, 0), 30); }
#pragma unroll
            for (int i = 0; i < 8; ++i) { const LAS float* rprow = RP + (h * 15 + (rs + i - r + 7)) * 31;
#pragma unroll
                for (int k8 = 0; k8 < 8; ++k8) { const int blk = 2 * i + (k8 >> 2), e = k8 & 3;
                    const float bia = rprow[cofs[k8]];
                    const float sb = acc[blk][e] * 0.125f + bia; const float s = okk[k8] ? sb : -3.0e38f;
                    acc[blk][e] = s; mx = fmaxf(mx, s); } }
            mx = fmaxf(mx, __shfl_xor(mx, 16)); mx = fmaxf(mx, __shfl_xor(mx, 32));
            float sum = 0.f;
#pragma unroll
            for (int blk = 0; blk < 16; ++blk)
#pragma unroll
                for (int e = 0; e < 4; ++e) { const float p = __builtin_amdgcn_exp2f((acc[blk][e] - mx) * 1.44269504089f); acc[blk][e] = p; sum += p; }
            sum += __shfl_xor(sum, 16); sum += __shfl_xor(sum, 32);
            const float inv = 1.0f / sum;
            f32x4 o[4];
#pragma unroll
            for (int db = 0; db < 4; ++db) o[db] = (f32x4){0.f, 0.f, 0.f, 0.f};
#pragma unroll
            for (int i = 0; i < 8; ++i) {
                v4u pw; pw.x = pk2(acc[2 * i][0], acc[2 * i][1]); pw.y = pk2(acc[2 * i][2], acc[2 * i][3]); pw.z = pk2(acc[2 * i + 1][0], acc[2 * i + 1][1]); pw.w = pk2(acc[2 * i + 1][2], acc[2 * i + 1][3]);
                const bf16x8 pf = __builtin_bit_cast(bf16x8, pw);
                const size_t vrow = (((size_t)h * 512 + b * 256 + rs + i) * 8 + (c0 >> 3) + q4) * 512;
#pragma unroll
                for (int db = 0; db < 4; ++db) { const bf16x8 vfrag = *(const bf16x8*)(VB + vrow + (16 * db + n) * 8);
                    o[db] = __builtin_amdgcn_mfma_f32_16x16x32_bf16(vfrag, pf, o[db], 0, 0, 0); }
            }
#pragma unroll
            for (int db = 0; db < 4; ++db) { v2u w; w.x = pk2(o[db][0] * inv, o[db][1] * inv); w.y = pk2(o[db][2] * inv, o[db][3] * inv);
                *(v2u*)(U + tokq * DM + h * 64 + 16 * db + 4 * q4) = w; }
        }
    }
    __syncthreads();
}
#define XB_TMO      128
#define XB_XCNT(j)  (256  + 64 * (j))
#define XB_XSUB(j)  (1280 + 64 * (j))
#define XB_XGEN(j)  (2304 + 64 * (j))
#define XB_TOP      3328
#define XB_TOPGEN   3392
#define XCD_BAR_WORDS 3456
#define XB_SPIN_CAP (1u << 18)

__device__ __forceinline__ unsigned xb_ld(unsigned* p)              { return __hip_atomic_load(p, __ATOMIC_RELAXED, __HIP_MEMORY_SCOPE_AGENT); }
__device__ __forceinline__ unsigned xb_add(unsigned* p, unsigned v) { return __hip_atomic_fetch_add(p, v, __ATOMIC_RELAXED, __HIP_MEMORY_SCOPE_AGENT); }
__device__ __forceinline__ unsigned xb_xcc_id() { return (unsigned)__builtin_amdgcn_s_getreg((3 << 11) | 20) & 0xFu; }
#define XB_SPIN(cond, bar) do { unsigned _sp = 0; while (cond) { __builtin_amdgcn_s_sleep(1); \
    if ((++_sp & 255u) == 0u) { if (xb_ld(&(bar)[XB_TMO])) break; if (_sp > XB_SPIN_CAP) { atomicAdd(&(bar)[XB_TMO], 1u); break; } } } } while (0)

struct XcdBarrier {
    unsigned* bar; unsigned x;
    volatile LAS unsigned* st;
};

__device__ __forceinline__ XcdBarrier xcd_barrier_post(unsigned* bar, volatile LAS unsigned* st) {
    XcdBarrier b; b.bar = bar; b.x = xb_xcc_id(); b.st = st;
    if (threadIdx.x == 0) (void)xb_add(&bar[XB_XCNT(b.x)], 1u);
    return b;
}
__device__ __forceinline__ void xcd_barrier_complete(unsigned* bar, unsigned x, unsigned& nloc, unsigned& nx) {
    const unsigned G = gridDim.x * gridDim.y * gridDim.z;
    unsigned sum, cnt, mine, sp = 0u;
    for (;;) {
        sum = 0u; cnt = 0u; mine = 0u;
#pragma unroll
        for (unsigned j = 0; j < 16; ++j) { const unsigned c = xb_ld(&bar[XB_XCNT(j)]); sum += c; cnt += (c > 0u) ? 1u : 0u; mine = (j == x) ? c : mine; }
        if (sum == G) break;
        __builtin_amdgcn_s_sleep(1);
        if ((++sp & 255u) == 0u) { if (xb_ld(&bar[XB_TMO])) break; if (sp > XB_SPIN_CAP) { atomicAdd(&bar[XB_TMO], 1u); break; } }
    }
    nloc = mine > 0u ? mine : 1u; nx = cnt > 0u ? cnt : 1u;
}

__device__ __forceinline__ void xcd_barrier(const XcdBarrier& b) {
    asm volatile("s_waitcnt vmcnt(0)" ::: "memory");
    __syncthreads();
    if (threadIdx.x == 0) {
        unsigned* bar = b.bar;
        __builtin_amdgcn_s_waitcnt(0);
        unsigned nloc = b.st[0], nx = b.st[1];
        if (nloc == 0u) { xcd_barrier_complete(bar, b.x, nloc, nx); b.st[0] = nloc; b.st[1] = nx; }
        const unsigned old = xb_add(&bar[XB_XSUB(b.x)], 1u);
        const unsigned gen = old / nloc;
        if (old + 1u == (gen + 1u) * nloc) {
            __builtin_amdgcn_fence(__ATOMIC_RELEASE, "agent");
            asm volatile("s_waitcnt vmcnt(0)" ::: "memory");
            const unsigned og = xb_add(&bar[XB_TOP], 1u);
            const unsigned tg = og / nx;
            if (og + 1u == (tg + 1u) * nx) xb_add(&bar[XB_TOPGEN], 1u);
            else XB_SPIN(xb_ld(&bar[XB_TOPGEN]) == tg, bar);
            __builtin_amdgcn_fence(__ATOMIC_ACQUIRE, "agent");
            xb_add(&bar[XB_XGEN(b.x)], 1u);
            asm volatile("s_waitcnt vmcnt(0)" ::: "memory");
        } else {
            XB_SPIN(xb_ld(&bar[XB_XGEN(b.x)]) == gen, bar);
            __builtin_amdgcn_fence(__ATOMIC_ACQUIRE, "agent");
            asm volatile("s_waitcnt vmcnt(0)" ::: "memory");
        }
    }
    __syncthreads();
}

constexpr size_t WS_BAR = 3 * MiB;
enum { I_X = 0, I_NMIX, I_NFFN, I_NFIN, I_HWIN, I_HBIN, I_HCW, I_HCB, I_FW1, I_FB1, I_FW2, I_FB2, I_FW3, I_FB3, I_FFREQ, I_FWOUT, I_DECAY, I_SKIP, I_HWOUT, I_HBOUT,
       I_NWQKV, I_NBQKV, I_RPB, I_NWO, I_NBO, I_WG, I_WU, I_WD };
__global__ void __launch_bounds__(512) fwd_kernel(Args args) {
    extern __shared__ __attribute__((aligned(16))) unsigned char lds_raw[];
    Frame F; F.lds = (LAS unsigned char*)lds_raw; F.tid = threadIdx.x; F.lane = F.tid & 63; F.wave = __builtin_amdgcn_readfirstlane(F.tid >> 6); F.G = gridDim.x; F.bid = blockIdx.x;
    cg::grid_group grid = cg::this_grid();
    volatile LAS unsigned* BST = (volatile LAS unsigned*)(F.lds + LDS_BYTES - 64);
    if (F.tid < 2) BST[F.tid] = 0u;
    __syncthreads();
    XcdBarrier xbar; xbar.bar = (unsigned*)(args.ws + WS_BAR); xbar.x = 0; xbar.st = BST;
#if MK_SINGLE
    xbar = xcd_barrier_post((unsigned*)(args.ws + WS_BAR), BST);
#endif
    unsigned char* ws = args.ws;
    const int lo = args.ph_lo, hi = args.ph_hi;
    float* part = (float*)(ws + WS_PART); float* rstd = (float*)(ws + WS_RSTD);
    bf16* Whin = (bf16*)(ws + WS_WHIN); bf16* Whout = (bf16*)(ws + WS_WHOUT); bf16* Wqkv = (bf16*)(ws + WS_WQKV); bf16* Wo = (bf16*)(ws + WS_WO);
    bf16* Wfo = (bf16*)(ws + WS_WFO); bf16* HF = (bf16*)(ws + WS_HF);
    bf16* XN = (bf16*)(ws + WS_XN); bf16* U = (bf16*)(ws + WS_U); bf16* Z = (bf16*)(ws + WS_Z); bf16* VT = (bf16*)(ws + WS_VT); bf16* UT = (bf16*)(ws + WS_UT); bf16* GT = (bf16*)(ws + WS_GT);
    float* X1 = args.out;
#define IN(k) (lo <= (k) && (k) < hi)
#ifndef PROBE_DOUBLE
#define PROBE_DOUBLE -1
#endif
#define REP(k) for (int rep_ = 0; rep_ < ((PROBE_DOUBLE) == (k) ? 2 : 1); ++rep_)
#define SEAM(k) do { if (IN(k) && IN((k) + 1)) xcd_barrier(xbar); } while (0)
    if (lo > hi) grid.sync();
    if (IN(0)) REP(0) {
        int base = 0;
        transpose_matrix(F, args.in[I_HWIN], 1024, 3072, args.in[I_NMIX], Whin, 0, base);
        transpose_matrix(F, args.in[I_HWOUT], 1024, 1024, nullptr, Whout, 0, base);
        transpose_matrix(F, args.in[I_NWQKV], 1024, 3072, args.in[I_NMIX] + 1024, Wqkv, 0, base);
        transpose_matrix(F, args.in[I_NWO], 1024, 1024, nullptr, Wo, 0, base);
        for (int l = 0; l < 2; ++l) {
            bf16* gu = (bf16*)(ws + (l ? WS_WGU1 : WS_WGU0)); bf16* wd = (bf16*)(ws + (l ? WS_WD1 : WS_WD0));
            transpose_matrix(F, args.in[I_WG] + (size_t)l * 1024 * FFH, 1024, FFH, args.in[I_NFFN] + l * 1024, gu, 1, base);
            transpose_matrix(F, args.in[I_WU] + (size_t)l * 1024 * FFH, 1024, FFH, args.in[I_NFFN] + l * 1024, gu, 2, base);
            transpose_matrix(F, args.in[I_WD] + (size_t)l * 1024 * FFH, FFH, 1024, nullptr, wd, 0, base);
        }
        { const float* wout = args.in[I_FWOUT];
          for (int idx = F.bid * 512 + F.tid; idx < 2048 * 128; idx += F.G * 512) { const int nn = idx >> 7, k = idx & 127; Wfo[idx] = k < 64 ? (bf16)f2bf(wout[k * 2048 + nn]) : (bf16)0; } }
        { const int gw = F.bid * 8 + F.wave, NGW = F.G * 8;
          for (int m = 4 * gw; m < MTOK; m += 4 * NGW) norm_rows4_to_bf16(args.in[I_X] + (size_t)m * DM, XN + (size_t)m * DM, F.lane); }
        filter_mlp(F, args.in[I_FW1], args.in[I_FB1], args.in[I_FW2], args.in[I_FB2], args.in[I_FW3], args.in[I_FB3], args.in[I_FFREQ], HF);
        __syncthreads();
    }
    SEAM(0);
    if (IN(1)) {
        { pg8::Gemm g{Whin, XN, 3072, MTOK, 1024}; pg8::StaticOrder S; S.init(3072, MTOK, F.G, F.bid);
          pg8::EpiT<0> E{Z, MTOK, args.in[I_HBIN], nullptr, 0.f};
          pg8::gemm_phase<pg8::EpiT<0>, pg8::StaticOrder, true, true>(F.lds, g, S, E); }
        { pg8::Gemm g{Wfo, HF, 2048, SEQL, 128}; pg8::StaticOrder S; S.init(2048, SEQL, F.G, F.bid);
          pg8::EpiT<2> E{GT, SEQL, args.in[I_DECAY], nullptr, 1.44269504089f / (float)(SEQL - 1)};
          pg8::gemm_phase<pg8::EpiT<2>, pg8::StaticOrder, true, true>(F.lds, g, S, E); }
    }
    SEAM(1);
    if (IN(2)) hyena_conv_phase<0>(F, Z, GT, args.in[I_HCW], args.in[I_HCB], args.in[I_SKIP], (float*)(ws + WS_XN), (float*)(ws + WS_U), UT);
#ifdef PROBE_FFT_VAR
    if (IN(2)) hyena_conv_phase<PROBE_FFT_VAR>(F, Z, GT, args.in[I_HCW], args.in[I_HCB], args.in[I_SKIP], (float*)(ws + WS_XN), (float*)(ws + WS_U), (bf16*)args.out);
#endif
    SEAM(2);
    if (IN(3)) REP(3) transpose_ut_phase(F, UT, U);
    SEAM(3);
    if (IN(4)) { pg8::Gemm g{U, Whout, MTOK, 1024, 1024}; pg8::StaticOrder S; S.init(MTOK, 1024, F.G, F.bid);
        pg8::EpiRes<true> E{args.in[I_X], XN, args.in[I_HBOUT], part};
        pg8::gemm_phase<pg8::EpiRes<true>, pg8::StaticOrder, true, true>(F.lds, g, S, E); }
    SEAM(4);
    if (IN(5)) { pg8::Gemm g{XN, (bf16*)(ws + WS_WGU0), MTOK, 2 * FFH, 1024}; pg8::StaticOrder S; S.init(MTOK, 2 * FFH, F.G, F.bid);
        pg8::EpiGU E{Z, part};
        pg8::gemm_phase<pg8::EpiGU, pg8::StaticOrder, true, true>(F.lds, g, S, E); }
    SEAM(5);
    if (IN(6)) { pg8::Gemm g{Z, (bf16*)(ws + WS_WD0), MTOK, 1024, FFH}; pg8::StaticOrder S; S.init(MTOK, 1024, F.G, F.bid);
        pg8::EpiRes<false> E{nullptr, XN, nullptr, part};
        pg8::gemm_phase<pg8::EpiRes<false>, pg8::StaticOrder, true, true>(F.lds, g, S, E); }
    SEAM(6);
    if (IN(7)) { for (int m = F.bid * 512 + F.tid; m < MTOK; m += F.G * 512) rstd[m] = pg8::rstd_from_partials(part, m); }
    SEAM(7);
    if (IN(8)) {
        { pg8::Gemm g{XN, Wqkv, MTOK, 2048, 1024}; pg8::StaticOrder S; S.init(MTOK, 2048, F.G, F.bid);
          pg8::EpiRowScale E{Z, 2048, args.in[I_NBQKV], rstd};
          pg8::gemm_phase<pg8::EpiRowScale, pg8::StaticOrder, true, true>(F.lds, g, S, E); }
        { pg8::Gemm g{Wqkv + (size_t)2048 * 1024, XN, 1024, MTOK, 1024}; pg8::StaticOrder S; S.init(1024, MTOK, F.G, F.bid);
          pg8::EpiT<1> E{VT, MTOK, args.in[I_NBQKV] + 2048, rstd, 0.f};
          pg8::gemm_phase<pg8::EpiT<1>, pg8::StaticOrder, true, true>(F.lds, g, S, E); }
    }
    SEAM(8);
    if (IN(9)) REP(9) na_phase(F, Z, VT, args.in[I_RPB], U);
    SEAM(9);
    if (IN(10)) { pg8::Gemm g{U, Wo, MTOK, 1024, 1024}; pg8::StaticOrder S; S.init(MTOK, 1024, F.G, F.bid);
        pg8::EpiRes<false> E{nullptr, XN, args.in[I_NBO], part};
        pg8::gemm_phase<pg8::EpiRes<false>, pg8::StaticOrder, true, true>(F.lds, g, S, E); }
    SEAM(10);
    if (IN(11)) { pg8::Gemm g{XN, (bf16*)(ws + WS_WGU1), MTOK, 2 * FFH, 1024}; pg8::StaticOrder S; S.init(MTOK, 2 * FFH, F.G, F.bid);
        pg8::EpiGU E{Z, part};
        pg8::gemm_phase<pg8::EpiGU, pg8::StaticOrder, true, true>(F.lds, g, S, E); }
    SEAM(11);
    if (IN(12)) { pg8::Gemm g{Z, (bf16*)(ws + WS_WD1), MTOK, 1024, FFH}; pg8::StaticOrder S; S.init(MTOK, 1024, F.G, F.bid);
        pg8::EpiRes<false> E{nullptr, XN, nullptr, part};
        pg8::gemm_phase<pg8::EpiRes<false>, pg8::StaticOrder, true, true>(F.lds, g, S, E); }
    SEAM(12);
    if (IN(13)) { const int gw = F.bid * 8 + F.wave, NGW = F.G * 8; const float* gf = args.in[I_NFIN];
        f32x4 gg[2][2];
#pragma unroll
        for (int j = 0; j < 2; ++j) { gg[j][0] = *((const f32x4*)gf + 2 * F.lane + 128 * j); gg[j][1] = *((const f32x4*)gf + 2 * F.lane + 128 * j + 1); }
        for (int m = 4 * gw; m < MTOK; m += 4 * NGW) {
            v4u w[4][2]; float rs[4];
#pragma unroll
            for (int r = 0; r < 4; ++r) { const v4u* xr = (const v4u*)(XN + (size_t)(m + r) * DM) + F.lane; w[r][0] = xr[0]; w[r][1] = xr[64]; rs[r] = pg8::rstd_from_partials(part, m + r); }
#pragma unroll
            for (int r = 0; r < 4; ++r) { f32x4* orow = (f32x4*)(X1 + (size_t)(m + r) * DM) + 2 * F.lane;
#pragma unroll
                for (int j = 0; j < 2; ++j) { const v4u q = w[r][j];
                    const f32x4 a = (f32x4){bflo(q.x), bfhi(q.x), bflo(q.y), bfhi(q.y)}, c = (f32x4){bflo(q.z), bfhi(q.z), bflo(q.w), bfhi(q.w)};
                    orow[128 * j] = a * rs[r] * gg[j][0]; orow[128 * j + 1] = c * rs[r] * gg[j][1]; } } } }
#undef IN
#undef SEAM
}

extern "C" void kernel_launch(void* const* d_in, const int* in_sizes, int n_in, void* d_out, int out_size, void* d_ws, size_t ws_size, hipStream_t stream) {
    static int grid = 0;
    if (grid == 0) {
        if (n_in != 28 || out_size != MTOK * DM || ws_size < WS_END) { fprintf(stderr, "kernel_launch: unexpected shapes (n_in %d out %d ws %zu)\n", n_in, out_size, ws_size); grid = -1; return; }
        int dev = 0, cus = 0, per_cu = 0;
        hipGetDevice(&dev); hipDeviceGetAttribute(&cus, hipDeviceAttributeMultiprocessorCount, dev);
        if (hipFuncSetAttribute((const void*)fwd_kernel, hipFuncAttributeMaxDynamicSharedMemorySize, LDS_BYTES) != hipSuccess) { fprintf(stderr, "kernel_launch: hipFuncSetAttribute failed\n"); grid = -1; return; }
        if (hipOccupancyMaxActiveBlocksPerMultiprocessor(&per_cu, (const void*)fwd_kernel, 512, LDS_BYTES) != hipSuccess || per_cu < 1) { fprintf(stderr, "kernel_launch: occupancy query failed (%d)\n", per_cu); (void)hipGetLastError(); per_cu = 1; }
        grid = cus * 1;
        fprintf(stderr, "kernel_launch: cus %d per_cu %d grid %d\n", cus, per_cu, grid);
    }
    if (grid < 0) return;
    Args a{};
    for (int i = 0; i < 28; ++i) a.in[i] = (const float*)d_in[i];
    a.out = (float*)d_out; a.ws = (unsigned char*)d_ws;
#if MK_SINGLE
    (void)hipMemsetAsync((unsigned char*)d_ws + WS_BAR, 0, 16384, stream);
    a.ph_lo = 0; a.ph_hi = NPHASE;
    void* kargs[] = {&a};
    hipError_t e = hipLaunchCooperativeKernel((const void*)fwd_kernel, dim3(grid), dim3(512), kargs, LDS_BYTES, stream);
    if (e != hipSuccess) fprintf(stderr, "cooperative launch failed: %s (grid %d)\n", hipGetErrorString(e), grid);
#else
    for (int p = 0; p < NPHASE; ++p) { a.ph_lo = p; a.ph_hi = p + 1; hipLaunchKernelGGL(fwd_kernel, dim3(grid), dim3(512), LDS_BYTES, stream, a); }
#endif
}
```

```cpp
#include <hip/hip_runtime.h>
#include <hip/hip_cooperative_groups.h>
#include <cstdio>
#include <cstdint>
namespace cg = cooperative_groups;
#ifndef MK_SINGLE
#define MK_SINGLE 1
#endif
namespace pg8 {
#define PG8_LAS __attribute__((address_space(3)))
typedef unsigned short bf16_t;
typedef short bf16x8 __attribute__((ext_vector_type(8)));
typedef float f32x4 __attribute__((ext_vector_type(4)));
typedef unsigned u32x4 __attribute__((ext_vector_type(4)));
constexpr int BM = 256, BK = 64, HALF = 128, HTB = HALF * BK * 2  , STAGE_BYTES = 8 * HTB, NXCD = 8, WGM = 8;

__host__ __device__ __forceinline__ int lds_byte(int r, int c) { const int st = (r >> 4) * 2 + (c >> 5), rr = r & 15, cc = c & 31, ob = rr * 64 + cc * 2; return st * 1024 + (ob ^ (((ob >> 9) & 1) << 5)); }
__host__ __device__ __forceinline__ void stage_rc(int b, int& R, int& C) { const int st = b / 1024, sb = b % 1024, swz = sb ^ (((sb >> 9) & 1) << 5); R = (st >> 1) * 16 + swz / 64; C = (st & 1) * 32 + (swz % 64) / 2; }
__host__ __device__ __forceinline__ int perm32(int rho) { const int n = rho >> 4, i = rho & 15; return 8 * (i >> 2) + 4 * n + (i & 3); }

struct Unit { int pm, pn; };
struct Gemm { const bf16_t* A; const bf16_t* Bt; int M, N, K; };

struct StaticOrder {
    int nM, nN, nwg, G, c;
    __host__ __device__ void init(int M, int N, int G_, int c_) { nM = M / BM; nN = N / BM; nwg = nM * nN; G = G_; c = c_; }
    __host__ __device__ bool next(int i, Unit& u) const {
        const long L = (long)i * G + c; if (L >= nwg) return false;
        int wgid = (int)L; { const int q = nwg / NXCD, r = nwg % NXCD, xcd = wgid % NXCD, off = wgid / NXCD; wgid = (xcd < r ? xcd * (q + 1) : r * (q + 1) + (xcd - r) * q) + off; }
        const int nig = WGM * nN, gid = wgid / nig, fm = gid * WGM, gsz = (nM - fm) < WGM ? (nM - fm) : WGM;
        u.pm = fm + ((wgid % nig) % gsz); u.pn = (wgid % nig) / gsz; return true;
    }
    __device__ __forceinline__ void a_ready(const Unit&) const {}
    __device__ __forceinline__ void done(const Unit&) const {}
};

__device__ __forceinline__ unsigned cvt_pk_bf16(float lo, float hi) { unsigned r; asm volatile("v_cvt_pk_bf16_f32 %0, %1, %2" : "=v"(r) : "v"(lo), "v"(hi)); return r; }
typedef float f32x2 __attribute__((ext_vector_type(2)));
typedef unsigned u32x4v __attribute__((ext_vector_type(4)));
__device__ __forceinline__ u32x4v pack8(const f32x4& a, const f32x4& b) { u32x4v w; w.x = cvt_pk_bf16(a[0], a[1]); w.y = cvt_pk_bf16(a[2], a[3]); w.z = cvt_pk_bf16(b[0], b[1]); w.w = cvt_pk_bf16(b[2], b[3]); return w; }
__device__ __forceinline__ float rstd_from_partials(const float* part, int row) {
    const f32x4* p = (const f32x4*)(part + (size_t)row * 16); const f32x4 a = p[0], b = p[1], c = p[2], d = p[3];
    const float s = ((a[0] + a[1]) + (a[2] + a[3])) + ((b[0] + b[1]) + (b[2] + b[3])) + ((c[0] + c[1]) + (c[2] + c[3])) + ((d[0] + d[1]) + (d[2] + d[3]));
    return __builtin_amdgcn_rsqf(s * (1.0f / 1024.0f) + 1e-6f);
}
template <int MODE> struct EpiT {
    static constexpr bool PERM = true, AFTER_DRAIN = false;
    bf16_t* O; int ldc; const float* rvec; const float* cscale; float kdec;
    __device__ __forceinline__ void operator()(const f32x4 (&acc)[2][2][4][2], const Unit& u, int wr, int wc, int fr, int fq) const {
        const int row0 = u.pm * BM + wr * 64 + fr, col0 = u.pn * BM + wc * 32 + 8 * fq;
        f32x4 cs[2][2];
        if (MODE == 1) {
#pragma unroll
            for (int bj = 0; bj < 2; ++bj)
#pragma unroll
                for (int n = 0; n < 2; ++n) cs[bj][n] = *(const f32x4*)(cscale + col0 + bj * HALF + 4 * n);
        }
#pragma unroll
        for (int ai = 0; ai < 2; ++ai)
#pragma unroll
            for (int m = 0; m < 4; ++m) { const int r = row0 + ai * HALF + m * 16; const float rv = rvec[r]; bf16_t* rowp = O + (size_t)r * ldc + col0;
                const float rk = (MODE == 2) ? fabsf(rv) * kdec : 0.f;
#pragma unroll
                for (int bj = 0; bj < 2; ++bj) { f32x4 v0 = acc[ai][bj][m][0], v1 = acc[ai][bj][m][1];
                    if (MODE == 0) { v0 = v0 + rv; v1 = v1 + rv; }
                    if (MODE == 1) { v0 = v0 * cs[bj][0] + rv; v1 = v1 * cs[bj][1] + rv; }
                    if (MODE == 2) { const float cb = (float)(col0 + bj * HALF);
#pragma unroll
                        for (int e = 0; e < 4; ++e) { v0[e] *= __builtin_amdgcn_exp2f(-(cb + (float)e) * rk); v1[e] *= __builtin_amdgcn_exp2f(-(cb + (float)(4 + e)) * rk); } }
                    if (MODE == 1) {
                        const int mtok = col0 + bj * HALF; const size_t o = ((((size_t)(r >> 6) * 512 + (mtok >> 6)) * 8 + ((mtok & 63) >> 3)) * 64 + (r & 63)) * 8;
                        *(u32x4v*)(O + o) = pack8(v0, v1);
                    } else
                    *(u32x4v*)(rowp + bj * HALF) = pack8(v0, v1); } }
    }
};
struct EpiRowScale {
    static constexpr bool PERM = true, AFTER_DRAIN = false;
    bf16_t* O; int ldc; const float* bias; const float* rstd;
    __device__ __forceinline__ void operator()(const f32x4 (&acc)[2][2][4][2], const Unit& u, int wr, int wc, int fr, int fq) const {
        const int row0 = u.pm * BM + wr * 64 + fr, col0 = u.pn * BM + wc * 32 + 8 * fq;
        f32x4 bv[2][2];
#pragma unroll
        for (int bj = 0; bj < 2; ++bj)
#pragma unroll
            for (int n = 0; n < 2; ++n) bv[bj][n] = *(const f32x4*)(bias + col0 + bj * HALF + 4 * n);
#pragma unroll
        for (int ai = 0; ai < 2; ++ai)
#pragma unroll
            for (int m = 0; m < 4; ++m) { const int r = row0 + ai * HALF + m * 16; const float rs = rstd[r]; bf16_t* rowp = O + (size_t)r * ldc + col0;
#pragma unroll
                for (int bj = 0; bj < 2; ++bj) { const f32x4 v0 = acc[ai][bj][m][0] * rs + bv[bj][0], v1 = acc[ai][bj][m][1] * rs + bv[bj][1];
                    const int c = col0 + bj * HALF;
                    (void)rowp; *(u32x4v*)(O + (((size_t)(c >> 6) * 2 + ((c >> 5) & 1)) * 32768 + r) * 32 + (c & 31)) = pack8(v0, v1); } }
    }
};
template <bool BASE_F32> struct EpiRes {
    static constexpr bool PERM = true, AFTER_DRAIN = false;
    const float* base; bf16_t* xb; const float* bias; float* part;
    __device__ __forceinline__ void operator()(const f32x4 (&acc)[2][2][4][2], const Unit& u, int wr, int wc, int fr, int fq) const {
        const int row0 = u.pm * BM + wr * 64 + fr, col0 = u.pn * BM + wc * 32 + 8 * fq;
        f32x4 bv[2][2];
#pragma unroll
        for (int bj = 0; bj < 2; ++bj)
#pragma unroll
            for (int n = 0; n < 2; ++n) bv[bj][n] = bias ? *(const f32x4*)(bias + col0 + bj * HALF + 4 * n) : (f32x4){0.f, 0.f, 0.f, 0.f};
#pragma unroll
        for (int ai = 0; ai < 2; ++ai) {
            f32x4 b0[4][2], b1[4][2];
#pragma unroll
            for (int m = 0; m < 4; ++m) { const size_t off = (size_t)(row0 + ai * HALF + m * 16) * 1024 + col0;
#pragma unroll
                for (int bj = 0; bj < 2; ++bj) {
                    if (BASE_F32) { b0[m][bj] = *(const f32x4*)(base + off + bj * HALF); b1[m][bj] = *(const f32x4*)(base + off + bj * HALF + 4); }
                    else { const u32x4v w = *(const u32x4v*)(xb + off + bj * HALF);
                        b0[m][bj] = (f32x4){__uint_as_float(w.x << 16), __uint_as_float(w.x & 0xffff0000u), __uint_as_float(w.y << 16), __uint_as_float(w.y & 0xffff0000u)};
                        b1[m][bj] = (f32x4){__uint_as_float(w.z << 16), __uint_as_float(w.z & 0xffff0000u), __uint_as_float(w.w << 16), __uint_as_float(w.w & 0xffff0000u)}; } } }
            __builtin_amdgcn_sched_barrier(0);
#pragma unroll
            for (int m = 0; m < 4; ++m) { const int r = row0 + ai * HALF + m * 16; const size_t off = (size_t)r * 1024 + col0; float ss = 0.f;
#pragma unroll
                for (int bj = 0; bj < 2; ++bj) {
                    const f32x4 v0 = acc[ai][bj][m][0] + bv[bj][0] + b0[m][bj], v1 = acc[ai][bj][m][1] + bv[bj][1] + b1[m][bj];
                    *(u32x4v*)(xb + off + bj * HALF) = pack8(v0, v1);
                    ss += (v0[0] * v0[0] + v0[1] * v0[1]) + (v0[2] * v0[2] + v0[3] * v0[3]) + (v1[0] * v1[0] + v1[1] * v1[1]) + (v1[2] * v1[2] + v1[3] * v1[3]); }
                ss += __shfl_xor(ss, 16); ss += __shfl_xor(ss, 32);
                if (fq == 0) part[(size_t)r * 16 + u.pn * 4 + wc] = ss; }
        }
    }
};
struct EpiGU {
    static constexpr bool PERM = true, AFTER_DRAIN = false;
    bf16_t* H; const float* part;
    __device__ __forceinline__ void operator()(const f32x4 (&acc)[2][2][4][2], const Unit& u, int wr, int wc, int fr, int fq) const {
        const int row0 = u.pm * BM + wr * 64 + fr, hc0 = u.pn * HALF + wc * 32 + 8 * fq;
#pragma unroll
        for (int ai = 0; ai < 2; ++ai)
#pragma unroll
            for (int m = 0; m < 4; ++m) { const int r = row0 + ai * HALF + m * 16; const float rs = rstd_from_partials(part, r);
                f32x4 o[2];
#pragma unroll
                for (int n = 0; n < 2; ++n) { const f32x4 g = acc[ai][0][m][n] * rs, up = acc[ai][1][m][n] * rs;
#pragma unroll
                    for (int e = 0; e < 4; ++e) o[n][e] = g[e] * __builtin_amdgcn_rcpf(1.0f + __builtin_amdgcn_exp2f(-1.44269504089f * g[e])) * up[e]; }
                *(u32x4v*)(H + (size_t)r * 2816 + hc0) = pack8(o[0], o[1]); }
    }
};
template <class Epi, class Sched, bool ALIGN_EPI = false, bool SP2 = false>
__device__ __forceinline__ void gemm_phase(PG8_LAS unsigned char* lds, const Gemm g, const Sched& S, const Epi& E) {
    const int tid = threadIdx.x, wid = __builtin_amdgcn_readfirstlane(tid >> 6), lane = tid & 63, wr = wid >> 2, wc = wid & 3, fr = lane & 15, fq = lane >> 4;
    const int K = g.K, nt = K / BK;
    unsigned voffA[2], voffB[2];
#pragma unroll
    for (int i = 0; i < 2; ++i) { int R, C; stage_rc(tid * 16 + i * 8192, R, C); const int Rb = Epi::PERM ? ((R & ~31) + perm32(R & 31)) : R;
        voffA[i] = (unsigned)(R * K + C) * 2u; voffB[i] = (unsigned)(Rb * K + C) * 2u; }
    const size_t kstep = (size_t)(BK * 2);
    const size_t hstep = (size_t)HALF * K * 2;
    const size_t tstep = 2 * hstep;
    const unsigned ldsw = (unsigned)wid * 1024u;
    const int aoff = lds_byte(wr * 64 + fr, fq * 8), boff = lds_byte(wc * 32 + fr, fq * 8);
#define PG8_SA(b, h) (((b) * 2 + (h)) * HTB)
#define PG8_SB(b, h) ((4 + (b) * 2 + (h)) * HTB)
#define PG8_STAGE(bufoff, gbase, voff) do { _Pragma("unroll") for (int _i = 0; _i < 2; ++_i) \
        __builtin_amdgcn_global_load_lds((const unsigned*)((const char*)(gbase) + (voff)[_i]), (PG8_LAS unsigned*)(lds + (bufoff) + ldsw + _i * 8192), 16, 0, 0); } while (0)
#define PG8_LDA(dst, b, h) do { _Pragma("unroll") for (int m = 0; m < 4; ++m) _Pragma("unroll") for (int k = 0; k < 2; ++k) dst[m][k] = *(const PG8_LAS bf16x8*)(lds + PG8_SA(b, h) + aoff + m * 2048 + k * 1024); } while (0)
#define PG8_LDB(dst, b, h) do { _Pragma("unroll") for (int n = 0; n < 2; ++n) _Pragma("unroll") for (int k = 0; k < 2; ++k) dst[n][k] = *(const PG8_LAS bf16x8*)(lds + PG8_SB(b, h) + boff + n * 2048 + k * 1024); } while (0)
#define PG8_MMA(ai, bj, At, Bt) do { __builtin_amdgcn_s_setprio(1); _Pragma("unroll") for (int m = 0; m < 4; ++m) _Pragma("unroll") for (int n = 0; n < 2; ++n) _Pragma("unroll") for (int k = 0; k < 2; ++k) \
        acc[ai][bj][m][n] = __builtin_amdgcn_mfma_f32_16x16x32_bf16(Bt[n][k], At[m][k], acc[ai][bj][m][n], 0, 0, 0); __builtin_amdgcn_s_setprio(0); } while (0)
#define PG8_WAIT_V(n) asm volatile("s_waitcnt vmcnt(" #n ")" ::: "memory")
#define PG8_WAIT_L(n) asm volatile("s_waitcnt lgkmcnt(" #n ")" ::: "memory")
#define PG8_BAR __builtin_amdgcn_s_barrier()
#define PG8_SCHED __builtin_amdgcn_sched_barrier(0)
    Unit cur, nxt; int ui = 0;
    if (!S.next(0, cur)) return;
    f32x4 acc[2][2][4][2];
#pragma unroll
    for (int a = 0; a < 2; ++a)
#pragma unroll
        for (int b = 0; b < 2; ++b)
#pragma unroll
            for (int m = 0; m < 4; ++m)
#pragma unroll
                for (int n = 0; n < 2; ++n) acc[a][b][m][n] = (f32x4){0.f, 0.f, 0.f, 0.f};
    bf16x8 At[4][2], B0[2][2], B1[2][2];
    const char* cA = (const char*)g.A + (size_t)cur.pm * tstep; const char* cB = (const char*)g.Bt + (size_t)cur.pn * tstep;
    S.a_ready(cur);
    if constexpr (SP2) {
        PG8_STAGE(PG8_SB(0, 0), cB, voffB); PG8_STAGE(PG8_SB(0, 1), cB + hstep, voffB); PG8_STAGE(PG8_SA(0, 0), cA, voffA); PG8_STAGE(PG8_SA(0, 1), cA + hstep, voffA);
        if (wr == 1) PG8_BAR;
        PG8_WAIT_V(2); PG8_BAR;
        PG8_STAGE(PG8_SB(1, 0), cB + kstep, voffB); PG8_STAGE(PG8_SA(1, 0), cA + kstep, voffA); PG8_STAGE(PG8_SB(1, 1), cB + hstep + kstep, voffB);
        PG8_WAIT_V(6); PG8_BAR;
    } else {
        PG8_STAGE(PG8_SB(0, 0), cB, voffB); PG8_STAGE(PG8_SA(0, 0), cA, voffA); PG8_STAGE(PG8_SB(0, 1), cB + hstep, voffB); PG8_STAGE(PG8_SA(0, 1), cA + hstep, voffA);
        if (wr == 1) PG8_BAR;
        PG8_WAIT_V(4); PG8_BAR;
        PG8_STAGE(PG8_SB(1, 0), cB + kstep, voffB); PG8_STAGE(PG8_SA(1, 0), cA + kstep, voffA); PG8_STAGE(PG8_SB(1, 1), cB + hstep + kstep, voffB);
        PG8_WAIT_V(6); PG8_BAR;
    }
    for (;;) {
        const bool has_next = S.next(ui + 1, nxt);
        const char* nA = has_next ? (const char*)g.A + (size_t)nxt.pm * tstep : cA; const char* nB = has_next ? (const char*)g.Bt + (size_t)nxt.pn * tstep : cB;
        for (int t = 0; t < nt; t += 2) {
            const bool last = (t == nt - 2);
            const char* a1 = cA + (size_t)(t + 1) * kstep;
            const char* a2 = last ? nA : cA + (size_t)(t + 2) * kstep; const char* b2 = last ? nB : cB + (size_t)(t + 2) * kstep;
            const char* a3 = a2 + kstep; const char* b3 = b2 + kstep;
            if (last && has_next) S.a_ready(nxt);
            if constexpr (SP2) {
            PG8_LDB(B0, 0, 0); PG8_LDB(B1, 0, 1); PG8_SCHED; PG8_LDA(At, 0, 0); PG8_STAGE(PG8_SA(1, 1), a1 + hstep, voffA);
            PG8_WAIT_V(8); PG8_WAIT_L(0); PG8_BAR; PG8_MMA(0, 0, At, B0); PG8_MMA(0, 1, At, B1); PG8_BAR; PG8_SCHED;
            PG8_LDA(At, 0, 1); PG8_STAGE(PG8_SB(0, 0), b2, voffB); PG8_STAGE(PG8_SB(0, 1), b2 + hstep, voffB); PG8_STAGE(PG8_SA(0, 0), a2, voffA);
            PG8_WAIT_V(8); PG8_WAIT_L(0); PG8_BAR; PG8_MMA(1, 0, At, B0); PG8_MMA(1, 1, At, B1); PG8_BAR; PG8_SCHED;
            PG8_LDB(B0, 1, 0); PG8_LDB(B1, 1, 1); PG8_SCHED; PG8_LDA(At, 1, 0); PG8_STAGE(PG8_SA(0, 1), a2 + hstep, voffA);
            PG8_WAIT_V(8); PG8_WAIT_L(0); PG8_BAR; PG8_MMA(0, 0, At, B0); PG8_MMA(0, 1, At, B1); PG8_BAR; PG8_SCHED;
            PG8_LDA(At, 1, 1); PG8_STAGE(PG8_SB(1, 0), b3, voffB); PG8_STAGE(PG8_SB(1, 1), b3 + hstep, voffB); PG8_STAGE(PG8_SA(1, 0), a3, voffA);
            PG8_WAIT_V(8); PG8_WAIT_L(0); PG8_BAR; PG8_MMA(1, 0, At, B0); PG8_MMA(1, 1, At, B1); PG8_BAR; PG8_SCHED;
            } else {
            PG8_LDB(B0, 0, 0); PG8_SCHED; PG8_LDA(At, 0, 0); PG8_STAGE(PG8_SA(1, 1), a1 + hstep, voffA);
            PG8_WAIT_L(8); PG8_BAR; PG8_WAIT_L(0); PG8_MMA(0, 0, At, B0); PG8_BAR; PG8_SCHED;
            PG8_LDB(B1, 0, 1); PG8_STAGE(PG8_SB(0, 0), b2, voffB);
            PG8_BAR; PG8_WAIT_L(0); PG8_MMA(0, 1, At, B1); PG8_BAR;
            PG8_LDA(At, 0, 1); PG8_STAGE(PG8_SA(0, 0), a2, voffA);
            PG8_BAR; PG8_WAIT_L(0); PG8_MMA(1, 0, At, B0); PG8_BAR; PG8_SCHED;
            PG8_STAGE(PG8_SB(0, 1), b2 + hstep, voffB);
            PG8_WAIT_V(6); PG8_BAR; PG8_MMA(1, 1, At, B1); PG8_BAR;
            PG8_LDB(B0, 1, 0); PG8_SCHED; PG8_LDA(At, 1, 0); PG8_STAGE(PG8_SA(0, 1), a2 + hstep, voffA);
            PG8_WAIT_L(8); PG8_BAR; PG8_WAIT_L(0); PG8_MMA(0, 0, At, B0); PG8_BAR; PG8_SCHED;
            PG8_LDB(B1, 1, 1); PG8_STAGE(PG8_SB(1, 0), b3, voffB);
            PG8_BAR; PG8_WAIT_L(0); PG8_MMA(0, 1, At, B1); PG8_BAR;
            PG8_LDA(At, 1, 1); PG8_STAGE(PG8_SA(1, 0), a3, voffA);
            PG8_BAR; PG8_WAIT_L(0); PG8_MMA(1, 0, At, B0); PG8_BAR; PG8_SCHED;
            PG8_STAGE(PG8_SB(1, 1), b3 + hstep, voffB);
            PG8_WAIT_V(6); PG8_BAR; PG8_MMA(1, 1, At, B1); PG8_BAR;
            }
        }
        if constexpr (ALIGN_EPI) { if (wr == 0) PG8_BAR; }
        if constexpr (!Epi::AFTER_DRAIN) { E(acc, cur, wr, wc, fr, fq); S.done(cur); }
        if (!has_next) break;
#pragma unroll
        for (int a = 0; a < 2; ++a)
#pragma unroll
            for (int b = 0; b < 2; ++b)
#pragma unroll
                for (int m = 0; m < 4; ++m)
#pragma unroll
                    for (int n = 0; n < 2; ++n) acc[a][b][m][n] = (f32x4){0.f, 0.f, 0.f, 0.f};
        cur = nxt; cA = nA; cB = nB; ++ui;
        if constexpr (ALIGN_EPI) { if (wr == 1) PG8_BAR; }
    }
    PG8_WAIT_V(0);
    if constexpr (!ALIGN_EPI) { if (wr == 0) PG8_BAR; }
    PG8_BAR;
    if constexpr (Epi::AFTER_DRAIN) { E.fused(acc, cur, wr, wc, fr, fq, lds, wid, lane); S.done(cur); }
#undef PG8_SA
#undef PG8_SB
#undef PG8_STAGE
#undef PG8_LDA
#undef PG8_LDB
#undef PG8_MMA
#undef PG8_WAIT_V
#undef PG8_WAIT_L
#undef PG8_BAR
#undef PG8_SCHED
}
}
constexpr int MB = 2, SEQL = 16384, DM = 1024, MTOK = MB * SEQL, FFH = 2816, NHEAD = 16;
constexpr size_t MiB = 1u << 20;
constexpr size_t WS_PART = 0;
constexpr size_t WS_RSTD = 2 * MiB;
constexpr size_t WS_WHIN = 4 * MiB;
constexpr size_t WS_WHOUT = 10 * MiB;
constexpr size_t WS_WQKV = 12 * MiB;
constexpr size_t WS_WO = 18 * MiB;
constexpr size_t WS_WGU0 = 20 * MiB, WS_WGU1 = 31 * MiB;
constexpr size_t WS_WD0 = 42 * MiB, WS_WD1 = 48 * MiB;
constexpr size_t WS_WFO = 54 * MiB;
constexpr size_t WS_HF = 56 * MiB;
constexpr size_t WS_XN = 64 * MiB;
constexpr size_t WS_U = 128 * MiB;
constexpr size_t WS_Z = 192 * MiB;
constexpr size_t WS_VT = WS_Z + 128 * MiB;
constexpr size_t WS_UT = 384 * MiB;
constexpr size_t WS_GT = 448 * MiB;
constexpr size_t WS_END = 512 * MiB;
constexpr int LDS_BYTES = 147456;
constexpr int NPHASE = 14;

#define LAS __attribute__((address_space(3)))
typedef unsigned short bf16;
typedef unsigned v4u __attribute__((ext_vector_type(4)));
typedef unsigned v2u __attribute__((ext_vector_type(2)));
typedef float f32x4 __attribute__((ext_vector_type(4)));
typedef short bf16x8 __attribute__((ext_vector_type(8)));
typedef short s16x4 __attribute__((ext_vector_type(4)));
__device__ __forceinline__ unsigned f2bf(float f) { unsigned u = __builtin_bit_cast(unsigned, f); return (u + 0x7fffu + ((u >> 16) & 1u)) >> 16; }
__device__ __forceinline__ unsigned pk2(float lo, float hi) { unsigned r; asm("v_cvt_pk_bf16_f32 %0, %1, %2" : "=v"(r) : "v"(lo), "v"(hi)); return r; }
__device__ __forceinline__ float bflo(unsigned w) { return __uint_as_float(w << 16); }
__device__ __forceinline__ float bfhi(unsigned w) { return __uint_as_float(w & 0xffff0000u); }
__device__ __forceinline__ float bf1(bf16 h) { return __uint_as_float((unsigned)h << 16); }
#define LDS_WAIT() asm volatile("s_waitcnt lgkmcnt(0)" ::: "memory")

struct Args {
    const float* in[28]; float* out; unsigned char* ws; int ph_lo, ph_hi;
};
struct Frame { LAS unsigned char* lds; int tid, lane, wave, G, bid; };

__device__ __forceinline__ float wave_sum(float v) {
#pragma unroll
    for (int o = 1; o < 64; o <<= 1) v += __shfl_xor(v, o);
    return v;
}
__device__ __forceinline__ void transpose_item(const float* W, int K, int N, const float* gain, bf16* WT, int out_row0, LAS float* scr, int k0, int n0, int lane) {
    f32x4 v[16];
#pragma unroll
    for (int i = 0; i < 16; ++i) { const int kk = 4 * i + (lane >> 4); v[i] = *(const f32x4*)(W + (size_t)(k0 + kk) * N + n0 + 4 * (lane & 15)); }
#pragma unroll
    for (int i = 0; i < 16; ++i) { const int kk = 4 * i + (lane >> 4); const float g = gain ? gain[k0 + kk] : 1.0f; LAS float* d = scr + kk * 65 + 4 * (lane & 15);
        d[0] = v[i].x * g; d[1] = v[i].y * g; d[2] = v[i].z * g; d[3] = v[i].w * g; }
    LDS_WAIT(); asm volatile("" ::: "memory");
    const int c = lane & 7;
#pragma unroll
    for (int j = 0; j < 8; ++j) { const int n = (lane >> 3) + 8 * j; const LAS float* s = scr + (8 * c) * 65 + n;
        v4u o; o.x = pk2(s[0 * 65], s[1 * 65]); o.y = pk2(s[2 * 65], s[3 * 65]); o.z = pk2(s[4 * 65], s[5 * 65]); o.w = pk2(s[6 * 65], s[7 * 65]);
        *(v4u*)(WT + (size_t)(out_row0 + n) * K + k0 + 8 * c) = o; }
    LDS_WAIT(); asm volatile("" ::: "memory");
}
__device__ __forceinline__ void transpose_matrix(const Frame& F, const float* W, int K, int N, const float* gain, bf16* WT, int kind, int& base) {
    LAS float* scr = (LAS float*)(F.lds + F.wave * 17408);
    const int nblk = N / 64, nitems = (K / 64) * nblk, gw = F.bid * 8 + F.wave, NGW = F.G * 8;
    int first = (gw - (base % NGW) + NGW) % NGW;
    for (int it = first; it < nitems; it += NGW) { const int kb = it / nblk, nb = it % nblk, n0 = nb * 64;
        int r0 = n0; if (kind) r0 = 256 * (n0 / 128) + (n0 % 128) + (kind == 2 ? 128 : 0);
        transpose_item(W, K, N, gain, WT, r0, scr, kb * 64, n0, F.lane); }
    base += nitems;
}
__device__ __forceinline__ void norm_rows4_to_bf16(const float* xrow, bf16* orow, int lane) {
    f32x4 v[4][4]; float s[4];
#pragma unroll
    for (int r = 0; r < 4; ++r) { const f32x4* xr = (const f32x4*)(xrow + (size_t)r * DM) + lane; s[r] = 0.f;
#pragma unroll
        for (int j = 0; j < 4; ++j) v[r][j] = xr[64 * j]; }
#pragma unroll
    for (int r = 0; r < 4; ++r) {
#pragma unroll
        for (int j = 0; j < 4; ++j) s[r] += (v[r][j].x * v[r][j].x + v[r][j].y * v[r][j].y) + (v[r][j].z * v[r][j].z + v[r][j].w * v[r][j].w); }
#pragma unroll
    for (int o = 1; o < 64; o <<= 1) {
#pragma unroll
        for (int r = 0; r < 4; ++r) s[r] += __shfl_xor(s[r], o); }
#pragma unroll
    for (int r = 0; r < 4; ++r) { const float rstd = __builtin_amdgcn_rsqf(s[r] * (1.0f / DM) + 1e-6f);
        unsigned long long* o8 = (unsigned long long*)(orow + (size_t)r * DM) + lane;
#pragma unroll
        for (int j = 0; j < 4; ++j) o8[64 * j] = (unsigned long long)pk2(v[r][j].x * rstd, v[r][j].y * rstd) | ((unsigned long long)pk2(v[r][j].z * rstd, v[r][j].w * rstd) << 32); }
}
__device__ __forceinline__ float rdl(float v, int l) { return __int_as_float(__builtin_amdgcn_readlane(__float_as_int(v), l)); }
__device__ __forceinline__ void filter_mlp(const Frame& F, const float* w1, const float* b1, const float* w2, const float* b2, const float* w3, const float* b3, const float* freq, bf16* HF) {
    const int gw = F.bid * 8 + F.wave, NGW = F.G * 8, lane = F.lane;
    const float fr = freq[lane], bb1 = b1[lane], bb2 = b2[lane], bb3 = b3[lane];
    const float band = 1e-4f + (float)(lane & 15) * ((15.0f - 1e-4f) / 15.0f);
    float W1r[33], W2r[64], W3r[64];
#pragma unroll
    for (int i = 0; i < 33; ++i) W1r[i] = w1[i * 64 + lane];
#pragma unroll
    for (int k = 0; k < 64; ++k) { W2r[k] = w2[k * 64 + lane]; W3r[k] = w3[k * 64 + lane]; }
    for (int pos = gw; pos < SEQL; pos += NGW) {
        const float t = (float)pos * (1.0f / (float)(SEQL - 1));
        const float w = 6.283185307179586f * (float)pos / (float)SEQL;
        const float arg = band * w; const float c = cosf(arg), s = -sinf(arg);
        float a = bb1 + t * W1r[0];
#pragma unroll
        for (int i = 0; i < 16; ++i) a += rdl(c, i) * W1r[1 + i] + rdl(s, i) * W1r[17 + i];
        float h = sinf(fr * a);
        a = bb2;
#pragma unroll
        for (int k = 0; k < 64; ++k) a += rdl(h, k) * W2r[k];
        h = sinf(fr * a);
        a = bb3;
#pragma unroll
        for (int k = 0; k < 64; ++k) a += rdl(h, k) * W3r[k];
        h = sinf(fr * a);
        HF[(size_t)pos * 128 + lane] = (bf16)f2bf(h); HF[(size_t)pos * 128 + 64 + lane] = 0;
    }
}
__device__ __forceinline__ constexpr int brev5(int x) { return ((x & 1) << 4) | ((x & 2) << 2) | (x & 4) | ((x & 8) >> 2) | ((x & 16) >> 4); }
#define TWR_LIST 1.000000000f, 0.995184727f, 0.980785280f, 0.956940336f, 0.923879533f, 0.881921264f, 0.831469612f, 0.773010453f, 0.707106781f, 0.634393284f, 0.555570233f, 0.471396737f, 0.382683432f, 0.290284677f, 0.195090322f, 0.098017140f, 0.000000000f, -0.098017140f, -0.195090322f, -0.290284677f, -0.382683432f, -0.471396737f, -0.555570233f, -0.634393284f, -0.707106781f, -0.773010453f, -0.831469612f, -0.881921264f, -0.923879533f, -0.956940336f, -0.980785280f, -0.995184727f
#define TWI_LIST -0.000000000f, -0.098017140f, -0.195090322f, -0.290284677f, -0.382683432f, -0.471396737f, -0.555570233f, -0.634393284f, -0.707106781f, -0.773010453f, -0.831469612f, -0.881921264f, -0.923879533f, -0.956940336f, -0.980785280f, -0.995184727f, -1.000000000f, -0.995184727f, -0.980785280f, -0.956940336f, -0.923879533f, -0.881921264f, -0.831469612f, -0.773010453f, -0.707106781f, -0.634393284f, -0.555570233f, -0.471396737f, -0.382683432f, -0.290284677f, -0.195090322f, -0.098017140f
typedef float f2 __attribute__((ext_vector_type(2)));
__device__ __forceinline__ f2 cmulw(f2 a, float wr, float wi) { const f2 s = __builtin_shufflevector(a, a, 1, 0); return s * (f2){-wi, wi} + a * (f2){wr, wr}; }
__device__ __forceinline__ f2 cmulc(f2 a, float wr, float wi) { const f2 s = __builtin_shufflevector(a, a, 1, 0); return s * (f2){wi, -wi} + a * (f2){wr, wr}; }
__device__ __forceinline__ f2 cmulr(f2 a, f2 c) { f2 t, r;
    asm("v_pk_mul_f32 %0, %1, %2 op_sel_hi:[1,0]" : "=v"(t) : "v"(a), "v"(c));
    asm("v_pk_fma_f32 %0, %1, %2, %3 op_sel:[1,1,0] op_sel_hi:[0,1,1] neg_lo:[0,1,0]" : "=v"(r) : "v"(a), "v"(c), "v"(t)); return r; }
__device__ __forceinline__ f2 cmulrc(f2 a, f2 c) { f2 t, r;
    asm("v_pk_mul_f32 %0, %1, %2 op_sel_hi:[1,0]" : "=v"(t) : "v"(a), "v"(c));
    asm("v_pk_fma_f32 %0, %1, %2, %3 op_sel:[1,1,0] op_sel_hi:[0,1,1] neg_hi:[0,1,0]" : "=v"(r) : "v"(a), "v"(c), "v"(t)); return r; }
__device__ __forceinline__ void fft32(f2 (&x)[32]) {
    constexpr float TWR[32] = {TWR_LIST}; constexpr float TWI[32] = {TWI_LIST};
#pragma unroll
    for (int h = 16; h >= 1; h >>= 1) {
#pragma unroll
        for (int i0 = 0; i0 < 32; i0 += 2 * h) {
#pragma unroll
            for (int j = 0; j < h; ++j) {
                const int i = i0 + j, k = i + h, m = j * (32 / h);
                const f2 a = x[i], b = x[k], d = a - b;
                x[i] = a + b;
                if (m == 0) x[k] = d;
                else if (m == 16) x[k] = (f2){d.y, -d.x};
                else x[k] = cmulw(d, TWR[m], TWI[m]);
            }
        }
    }
}
__device__ __forceinline__ void ifft32(f2 (&x)[32]) {
    constexpr float TWR[32] = {TWR_LIST}; constexpr float TWI[32] = {TWI_LIST};
#pragma unroll
    for (int h = 1; h <= 16; h <<= 1) {
#pragma unroll
        for (int i0 = 0; i0 < 32; i0 += 2 * h) {
#pragma unroll
            for (int j = 0; j < h; ++j) {
                const int i = i0 + j, k = i + h, m = j * (32 / h);
                const f2 a = x[i], y = x[k];
                f2 b;
                if (m == 0) b = y;
                else if (m == 16) b = (f2){-y.y, y.x};
                else b = cmulc(y, TWR[m], TWI[m]);
                x[i] = a + b; x[k] = a - b;
            }
        }
    }
}
constexpr int XP = 528;
constexpr int FFT_CT = 32 * XP * 8;
template <bool CONJ> __device__ __forceinline__ void twiddle32(f2 (&x)[32], float wr, float wi) {
    asm volatile("" : "+v"(wr), "+v"(wi));
    f2 c = (f2){wr, CONJ ? -wi : wi}; const f2 w = c;
#pragma unroll
    for (int k = 1; k < 32; ++k) { const int p = brev5(k); x[p] = cmulr(x[p], c); if (k < 31) c = cmulr(c, w); }
}
template <bool CONJ> __device__ __forceinline__ void twiddleN(f2 (&x)[32], float wr, float wi) {
    float sr = 0.995184727f, si = CONJ ? 0.098017140f : -0.098017140f;
    asm volatile("" : "+v"(wr), "+v"(wi), "+v"(sr), "+v"(si));
    f2 e = (f2){wr, CONJ ? -wi : wi}; const f2 st = (f2){sr, si};
#pragma unroll
    for (int n1 = 0; n1 < 32; ++n1) { x[n1] = cmulr(x[n1], e); if (n1 < 31) e = cmulr(e, st); }
}
__device__ __forceinline__ float lx1(float v) { return __int_as_float(__builtin_amdgcn_update_dpp(0, __float_as_int(v), 0xB1, 0xF, 0xF, true)); }
__device__ __forceinline__ float lx2(float v) { return __int_as_float(__builtin_amdgcn_update_dpp(0, __float_as_int(v), 0x4E, 0xF, 0xF, true)); }
__device__ __forceinline__ float lx4(float v) { return __int_as_float(__builtin_amdgcn_ds_swizzle(__float_as_int(v), 0x101F)); }
__device__ __forceinline__ float lx8(float v) { return __int_as_float(__builtin_amdgcn_update_dpp(0, __float_as_int(v), 0x128, 0xF, 0xF, true)); }
#define LBAR() do { asm volatile("s_waitcnt lgkmcnt(0)" ::: "memory"); __builtin_amdgcn_s_barrier(); asm volatile("" ::: "memory"); } while (0)
struct M2C { float w2r, w2i, t8r, t8i, t4r, t4i, t2r, t2i, s8, s4, s2, s1; };
__device__ __forceinline__ M2C m2c_load(LAS const M2C* MC) { M2C c; LAS const float* q = (LAS const float*)MC; c.w2r = q[0]; c.w2i = q[1]; c.t8r = q[2]; c.t8i = q[3]; c.t4r = q[4]; c.t4i = q[5]; c.t2r = q[6]; c.t2i = q[7]; c.s8 = q[8]; c.s4 = q[9]; c.s2 = q[10]; c.s1 = q[11]; return c; }
__device__ __forceinline__ void fft_forward(f2 (&x)[32], LAS f2* X, int t, LAS const float* W1, LAS const M2C* MC) {
    fft32(x);
    { const float wr = W1[0], wi = W1[1]; twiddle32<false>(x, wr * wr - wi * wi, 2.f * wr * wi); }
    LAS f2* wp = X + t; LAS const f2* rp = X + (t >> 4) * XP + (t & 15); LAS f2* wp1 = wp + 16 * XP; LAS const f2* rp1 = rp + 256;
    asm volatile("" : "+v"(wp), "+v"(rp), "+v"(wp1), "+v"(rp1));
#pragma unroll
    for (int k = 0; k < 16; ++k) { wp[k * XP] = x[brev5(k)]; wp1[k * XP] = x[brev5(k + 16)]; }
    LBAR();
#pragma unroll
    for (int m = 0; m < 16; ++m) { x[m] = rp[16 * m]; x[m + 16] = rp1[16 * m]; }
    LBAR();
    fft32(x);
    const M2C c = m2c_load(MC); const f2 t8 = (f2){c.t8r, c.t8i}, t4 = (f2){c.t4r, c.t4i}, t2 = (f2){c.t2r, c.t2i};
    twiddle32<false>(x, c.w2r, c.w2i);
#pragma unroll
    for (int p = 0; p < 32; ++p) {
        f2 v = x[p], pr;
        pr = (f2){lx8(v.x), lx8(v.y)}; v = cmulr(pr + v * c.s8, t8);
        pr = (f2){lx4(v.x), lx4(v.y)}; v = cmulr(pr + v * c.s4, t4);
        pr = (f2){lx2(v.x), lx2(v.y)}; v = cmulr(pr + v * c.s2, t2);
        pr = (f2){lx1(v.x), lx1(v.y)}; x[p] = pr + v * c.s1;
    }
}
__device__ __forceinline__ void fft_inverse(f2 (&x)[32], LAS f2* X, int t, LAS const float* W1, LAS const M2C* MC) {
    const M2C c = m2c_load(MC); const f2 t8 = (f2){c.t8r, c.t8i}, t4 = (f2){c.t4r, c.t4i}, t2 = (f2){c.t2r, c.t2i};
#pragma unroll
    for (int p = 0; p < 32; ++p) {
        f2 v = x[p], pr;
        pr = (f2){lx1(v.x), lx1(v.y)}; v = cmulrc(pr + v * c.s1, t2);
        pr = (f2){lx2(v.x), lx2(v.y)}; v = cmulrc(pr + v * c.s2, t4);
        pr = (f2){lx4(v.x), lx4(v.y)}; v = cmulrc(pr + v * c.s4, t8);
        pr = (f2){lx8(v.x), lx8(v.y)}; x[p] = pr + v * c.s8;
    }
    twiddle32<true>(x, c.w2r, c.w2i);
    ifft32(x);
    LAS f2* wp = X + (t >> 4) * XP + (t & 15); LAS const f2* rp = X + t; LAS f2* wp1 = wp + 256; LAS const f2* rp1 = rp + 16 * XP;
    asm volatile("" : "+v"(wp), "+v"(rp), "+v"(wp1), "+v"(rp1));
#pragma unroll
    for (int m = 0; m < 16; ++m) { wp[16 * m] = x[m]; wp1[16 * m] = x[m + 16]; }
    LBAR();
#pragma unroll
    for (int k = 0; k < 16; ++k) { x[brev5(k)] = rp[k * XP]; x[brev5(k + 16)] = rp1[k * XP]; }
    LBAR();
    { const float wr = W1[0], wi = W1[1]; twiddle32<true>(x, wr * wr - wi * wi, 2.f * wr * wi); }
    ifft32(x);
}
__device__ __forceinline__ void conv8(const bf16* row, int p0, float c0, float c1, float c2, float cb, float (&o)[8]) {
    const v4u w = *(const v4u*)(row + p0);
    float x[10];
    x[0] = bf1(row[p0 > 0 ? p0 - 1 : 0]) * (p0 > 0 ? 1.f : 0.f); x[9] = bf1(row[p0 + 8 < SEQL ? p0 + 8 : SEQL - 1]) * (p0 + 8 < SEQL ? 1.f : 0.f);
    x[1] = bflo(w.x); x[2] = bfhi(w.x); x[3] = bflo(w.y); x[4] = bfhi(w.y); x[5] = bflo(w.z); x[6] = bfhi(w.z); x[7] = bflo(w.w); x[8] = bfhi(w.w);
#pragma unroll
    for (int e = 0; e < 8; ++e) o[e] = c0 * x[e] + c1 * x[e + 1] + c2 * x[e + 2] + cb;
}
template <int VAR> __device__ __forceinline__ void hyena_conv_phase(const Frame& F, const bf16* ZT, const bf16* GT, const float* conv_w, const float* conv_b, const float* skip, float* gscr, float* zscr, bf16* UT) {
    LAS float* X = (LAS float*)F.lds; LAS f2* X2 = (LAS f2*)F.lds;
    const int t0 = F.tid;
    LAS float* W1 = (LAS float*)(F.lds + FFT_CT) + 2 * t0;
    LAS M2C* MCT = (LAS M2C*)(F.lds + FFT_CT + 4096);
    LAS float* RED = (LAS float*)(F.lds + FFT_CT + 4096 + 16 * 48);
    { float s, c; sincospif(-2.0f * (float)t0 / 32768.0f, &s, &c); W1[0] = c; W1[1] = s;
      if (t0 < 16) { const int m2 = t0; M2C k; sincospif(-2.0f * (float)m2 / 512.0f, &s, &c); k.w2r = c; k.w2i = s;
          sincospif(-2.0f * (float)(m2 & 7) / 16.0f, &s, &c); k.t8r = (m2 & 8) ? c : 1.f; k.t8i = (m2 & 8) ? s : 0.f; k.s8 = (m2 & 8) ? -1.f : 1.f;
          sincospif(-2.0f * (float)(m2 & 3) / 8.0f, &s, &c); k.t4r = (m2 & 4) ? c : 1.f; k.t4i = (m2 & 4) ? s : 0.f; k.s4 = (m2 & 4) ? -1.f : 1.f;
          k.t2r = (m2 & 2) ? ((m2 & 1) ? 0.f : 1.f) : 1.f; k.t2i = (m2 & 2) ? ((m2 & 1) ? -1.f : 0.f) : 0.f; k.s2 = (m2 & 2) ? -1.f : 1.f;
          k.s1 = (m2 & 1) ? -1.f : 1.f; LAS float* q = (LAS float*)(MCT + m2); q[0] = k.w2r; q[1] = k.w2i; q[2] = k.t8r; q[3] = k.t8i; q[4] = k.t4r; q[5] = k.t4i; q[6] = k.t2r; q[7] = k.t2i; q[8] = k.s8; q[9] = k.s4; q[10] = k.s2; q[11] = k.s1; } }
    __syncthreads();
    LAS const M2C* MC = MCT + (t0 & 15);
    typedef __attribute__((address_space(1))) unsigned gu32; typedef __attribute__((address_space(1))) v4u gv4;
    (void)gscr;
    gu32* zs = (gu32*)((unsigned*)zscr + (size_t)F.bid * 32768);
    for (int c = F.bid; c < DM; c += F.G) {
        const bf16* rx0 = ZT + (size_t)c * MTOK; const bf16* rx1 = ZT + (size_t)(DM + c) * MTOK; const bf16* rv = ZT + (size_t)(2 * DM + c) * MTOK;
        const float a0 = conv_w[c], a1 = conv_w[3072 + c], a2 = conv_w[6144 + c], ab = conv_b[c];
        const float b0 = conv_w[DM + c], b1 = conv_w[3072 + DM + c], b2 = conv_w[6144 + DM + c], bb = conv_b[DM + c];
        const float v0 = conv_w[2 * DM + c], v1 = conv_w[3072 + 2 * DM + c], v2 = conv_w[6144 + 2 * DM + c], vb = conv_b[2 * DM + c];
        const bf16* gf = GT + (size_t)c * SEQL; const bf16* gb = GT + (size_t)(DM + c) * SEQL;
        int t = t0; asm volatile("" : "+v"(t));
        float gsc = 1.f; const float skn = skip[c] * (1.0f / 32768.0f);
#pragma unroll
        for (int qi = 0; qi < 8; ++qi) { const int q = t + 512 * qi; const int b = qi >> 2, p0 = (q & 2047) * 8; float cv[8], cx[8];
            conv8(rv + b * SEQL, p0, v0, v1, v2, vb, cv); conv8(rx1 + b * SEQL, p0, b0, b1, b2, bb, cx);
            f32x4 o0, o1;
#pragma unroll
            for (int e = 0; e < 4; ++e) { o0[e] = cv[e] * cx[e]; o1[e] = cv[4 + e] * cx[4 + e]; }
            *(LAS f32x4*)(X + b * SEQL + p0) = o0; *(LAS f32x4*)(X + b * SEQL + p0 + 4) = o1; }
        __syncthreads();
        { gv4* pz = (gv4*)zs + t; LAS const float* x0p = X + t; LAS const float* x1p = X + SEQL + t; asm volatile("" : "+v"(x0p), "+v"(x1p), "+v"(pz));
#pragma unroll
          for (int g = 0; g < 8; ++g) { v4u w; w.x = pk2(x0p[512 * (4 * g)], x1p[512 * (4 * g)]); w.y = pk2(x0p[512 * (4 * g + 1)], x1p[512 * (4 * g + 1)]); w.z = pk2(x0p[512 * (4 * g + 2)], x1p[512 * (4 * g + 2)]); w.w = pk2(x0p[512 * (4 * g + 3)], x1p[512 * (4 * g + 3)]);
              *pz = w; pz += 512; asm volatile("" : "+v"(pz)); } }
        __syncthreads();
        unsigned dpk[16]; unsigned gpre[32];
#pragma unroll 1
        for (int jit = 0; jit < 4; ++jit) {
            const int job = (jit == 1) ? 2 : (jit == 2) ? 1 : jit;
            const int half = job & 1;
            f2 x[32];
            int t = t0; asm volatile("" : "+v"(t));
            if (job == 1) {
#pragma unroll
                for (int n1 = 0; n1 < 32; n1 += 2) { const unsigned w = dpk[n1 >> 1]; x[n1] = (f2){bflo(w), 0.f}; x[n1 + 1] = (f2){bfhi(w), 0.f}; }
            } else if (job == 0) { const bf16* pf = gf + t; const bf16* pb = gb + (SEQL - t); float asum = 0.f; float dprev = 0.f;
#pragma unroll
                for (int n1 = 0; n1 < 32; ++n1) { const float f = bf1(*pf), bk = (n1 == 0 && t == 0) ? 0.f : bf1(*pb); pf += 512; pb -= 512; asm volatile("" : "+v"(pf), "+v"(pb));
                    x[n1] = (f2){f + bk, 0.f}; asum += fabsf(f) + fabsf(bk);
                    if (n1 & 1) dpk[n1 >> 1] = pk2(dprev, f - bk); else dprev = f - bk; }
                {
                    float v = asum; v += lx1(v); v += lx2(v); v += lx4(v); v += lx8(v);
                    v += __int_as_float(__builtin_amdgcn_ds_swizzle(__float_as_int(v), 0x401F));
                    const float w64 = rdl(v, 0) + rdl(v, 32);
                    if (F.lane == 0) RED[F.wave] = w64;
                    __syncthreads();
                    const float tot = ((RED[0] + RED[1]) + (RED[2] + RED[3])) + ((RED[4] + RED[5]) + (RED[6] + RED[7]));
                    __syncthreads();
                    gsc = 1.0f / (tot * 32768.0f); }
            } else { const gv4* pz = (const gv4*)zs + t;
#pragma unroll
                for (int g = 0; g < 8; ++g) { const v4u w = *pz; pz += 512; asm volatile("" : "+v"(pz));
                    x[4 * g] = (f2){bflo(w.x), bfhi(w.x)}; x[4 * g + 1] = (f2){bflo(w.y), bfhi(w.y)}; x[4 * g + 2] = (f2){bflo(w.z), bfhi(w.z)}; x[4 * g + 3] = (f2){bflo(w.w), bfhi(w.w)}; }
            }
            if (half) twiddleN<false>(x, W1[0], W1[1]);
            if (VAR != 1) fft_forward(x, X2, t, W1, MC);
            if (job < 2) {
#pragma unroll
                for (int p = 0; p < 32; ++p) gpre[p] = pk2(x[p].x * gsc + skn, x[p].y * gsc);
            } else {
#pragma unroll
                for (int p = 0; p < 32; ++p) { const unsigned w = gpre[p]; x[p] = cmulr(x[p], (f2){bflo(w), bfhi(w)}); }
                gv4* py = (gv4*)(zs + 16384) + t;
                if (VAR != 1) fft_inverse(x, X2, t, W1, MC);
                if (half == 0) {
#pragma unroll
                    for (int g = 0; g < 8; ++g) { v4u w; w.x = pk2(x[4 * g].x, x[4 * g].y); w.y = pk2(x[4 * g + 1].x, x[4 * g + 1].y); w.z = pk2(x[4 * g + 2].x, x[4 * g + 2].y); w.w = pk2(x[4 * g + 3].x, x[4 * g + 3].y);
                        *py = w; py += 512; asm volatile("" : "+v"(py)); }
                } else {
                    twiddleN<true>(x, W1[0], W1[1]);
                    LAS float* x0p = X + t; LAS float* x1p = X + SEQL + t; asm volatile("" : "+v"(x0p), "+v"(x1p));
#pragma unroll
                    for (int g = 0; g < 8; ++g) { const v4u w = *py; py += 512; asm volatile("" : "+v"(py));
                        x0p[512 * (4 * g)] = x[4 * g].x + bflo(w.x); x1p[512 * (4 * g)] = x[4 * g].y + bfhi(w.x); x0p[512 * (4 * g + 1)] = x[4 * g + 1].x + bflo(w.y); x1p[512 * (4 * g + 1)] = x[4 * g + 1].y + bfhi(w.y);
                        x0p[512 * (4 * g + 2)] = x[4 * g + 2].x + bflo(w.z); x1p[512 * (4 * g + 2)] = x[4 * g + 2].y + bfhi(w.z); x0p[512 * (4 * g + 3)] = x[4 * g + 3].x + bflo(w.w); x1p[512 * (4 * g + 3)] = x[4 * g + 3].y + bfhi(w.w); }
                }
            }
        }
        __syncthreads();
        int te = t0; asm volatile("" : "+v"(te));
#pragma unroll
        for (int qi = 0; qi < 8; ++qi) { const int q = te + 512 * qi; const int b = qi >> 2, p0 = (q & 2047) * 8; float c0[8];
            conv8(rx0 + b * SEQL, p0, a0, a1, a2, ab, c0);
            const f32x4 y0 = *(LAS f32x4*)(X + b * SEQL + p0), y1 = *(LAS f32x4*)(X + b * SEQL + p0 + 4);
            float u[8];
#pragma unroll
            for (int e = 0; e < 4; ++e) { u[e] = y0[e] * c0[e]; u[4 + e] = y1[e] * c0[4 + e]; }
            v4u o; o.x = pk2(u[0], u[1]); o.y = pk2(u[2], u[3]); o.z = pk2(u[4], u[5]); o.w = pk2(u[6], u[7]);
            *(v4u*)(UT + (size_t)c * MTOK + b * SEQL + p0) = o; }
        __syncthreads();
    }
}
__device__ __forceinline__ void transpose_ut_phase(const Frame& F, const bf16* UT, bf16* U) {
    LAS unsigned short* T = (LAS unsigned short*)F.lds;
    const int t = F.tid;
    for (int tile = F.bid; tile < 16 * 128; tile += F.G) { const int c0 = (tile & 15) * 64, m0 = (tile >> 4) * 256;
#pragma unroll
        for (int i = 0; i < 4; ++i) { const int ch = (t >> 5) + 16 * i, seg = t & 31;
            const v4u w = *(const v4u*)(UT + (size_t)(c0 + ch) * MTOK + m0 + seg * 8);
            LAS unsigned* d = (LAS unsigned*)(T + ch * 258 + seg * 8); d[0] = w.x; d[1] = w.y; d[2] = w.z; d[3] = w.w; }
        __syncthreads();
#pragma unroll
        for (int i = 0; i < 4; ++i) { const int cg8 = t & 7, j = (t >> 3) + 64 * i;
            unsigned short v[8];
#pragma unroll
            for (int e = 0; e < 8; ++e) v[e] = T[(8 * cg8 + e) * 258 + j];
            v4u o; o.x = v[0] | ((unsigned)v[1] << 16); o.y = v[2] | ((unsigned)v[3] << 16); o.z = v[4] | ((unsigned)v[5] << 16); o.w = v[6] | ((unsigned)v[7] << 16);
            *(v4u*)(U + (size_t)(m0 + j) * DM + c0 + 8 * cg8) = o; }
        __syncthreads();
    }
}
__device__ __forceinline__ void na_phase(const Frame& F, const bf16* QH, const bf16* VB, const float* rpb, bf16* U) {
    const bf16* KH = QH + (size_t)16 * MTOK * 64;
    LAS float* RP = (LAS float*)F.lds;
    for (int i = F.tid; i < 16 * 465; i += 512) RP[i] = rpb[i];
    __syncthreads();
    const int lane = F.lane, n = lane & 15, q4 = lane >> 4;
    const int vcu = (F.G % 8 == 0) ? (F.bid % 8) * (F.G / 8) + F.bid / 8 : F.bid;
    for (int br = vcu; br < MB * 256; br += F.G) {
        const int b = br >> 8, r = br & 255;
        const int rs = min(max(r - 4, 0), 248);
#pragma unroll 1
        for (int it = 0; it < 8; ++it) {
            const int hj = it * 8 + F.wave, h = hj >> 2, j = hj & 3;
            const int c0 = (j == 0) ? 0 : (j == 1) ? 8 : (j == 2) ? 24 : 32;
            const int qcol = 16 * j + n, cs = min(max(qcol - 8, 0), 48);
            const size_t tokq = (size_t)b * SEQL + r * 64 + qcol;
            bf16x8 qf[2];
#pragma unroll
            for (int ks = 0; ks < 2; ++ks) qf[ks] = *(const bf16x8*)(QH + (((size_t)h * 2 + ks) * MTOK + tokq) * 32 + q4 * 8);
            f32x4 acc[16];
#pragma unroll
            for (int blk = 0; blk < 16; ++blk) { const int i = blk >> 1, hf = blk & 1;
                const size_t tokk = (size_t)b * SEQL + (rs + i) * 64 + c0 + 8 * (n >> 2) + 4 * hf + (n & 3);
                const bf16* kp = KH + ((size_t)h * 2 * MTOK + tokk) * 32 + q4 * 8; const bf16x8 k0 = *(const bf16x8*)kp, k1 = *(const bf16x8*)(kp + (size_t)MTOK * 32);
                f32x4 a = (f32x4){0.f, 0.f, 0.f, 0.f};
                a = __builtin_amdgcn_mfma_f32_16x16x32_bf16(k0, qf[0], a, 0, 0, 0);
                a = __builtin_amdgcn_mfma_f32_16x16x32_bf16(k1, qf[1], a, 0, 0, 0);
                acc[blk] = a; }
            float mx = -3.0e38f;
            int cofs[8]; bool okk[8];
#pragma unroll
            for (int k8 = 0; k8 < 8; ++k8) { const int kc = c0 + 8 * q4 + 4 * (k8 >> 2) + (k8 & 3); okk[k8] = (kc >= cs) && (kc < cs + 16); cofs[k8] = min(max(kc - qcol + 15, 0), 30); }
#pragma unroll
            for (int i = 0; i < 8; ++i) { const LAS float* rprow = RP + (h * 15 + (rs + i - r + 7)) * 31;
#pragma unroll
                for (int k8 = 0; k8 < 8; ++k8) { const int blk = 2 * i + (k8 >> 2), e = k8 & 3;
                    const float bia = rprow[cofs[k8]];
                    const float sb = acc[blk][e] * 0.125f + bia; const float s = okk[k8] ? sb : -3.0e38f;
                    acc[blk][e] = s; mx = fmaxf(mx, s); } }
            mx = fmaxf(mx, __shfl_xor(mx, 16)); mx = fmaxf(mx, __shfl_xor(mx, 32));
            float sum = 0.f;
#pragma unroll
            for (int blk = 0; blk < 16; ++blk)
#pragma unroll
                for (int e = 0; e < 4; ++e) { const float p = __builtin_amdgcn_exp2f((acc[blk][e] - mx) * 1.44269504089f); acc[blk][e] = p; sum += p; }
            sum += __shfl_xor(sum, 16); sum += __shfl_xor(sum, 32);
            const float inv = 1.0f / sum;
            f32x4 o[4];
#pragma unroll
            for (int db = 0; db < 4; ++db) o[db] = (f32x4){0.f, 0.f, 0.f, 0.f};
#pragma unroll
            for (int i = 0; i < 8; ++i) {
                v4u pw; pw.x = pk2(acc[2 * i][0], acc[2 * i][1]); pw.y = pk2(acc[2 * i][2], acc[2 * i][3]); pw.z = pk2(acc[2 * i + 1][0], acc[2 * i + 1][1]); pw.w = pk2(acc[2 * i + 1][2], acc[2 * i + 1][3]);
                const bf16x8 pf = __builtin_bit_cast(bf16x8, pw);
                const size_t vrow = (((size_t)h * 512 + b * 256 + rs + i) * 8 + (c0 >> 3) + q4) * 512;
#pragma unroll
                for (int db = 0; db < 4; ++db) { const bf16x8 vfrag = *(const bf16x8*)(VB + vrow + (16 * db + n) * 8);
                    o[db] = __builtin_amdgcn_mfma_f32_16x16x32_bf16(vfrag, pf, o[db], 0, 0, 0); }
            }
#pragma unroll
            for (int db = 0; db < 4; ++db) { v2u w; w.x = pk2(o[db][0] * inv, o[db][1] * inv); w.y = pk2(o[db][2] * inv, o[db][3] * inv);
                *(v2u*)(U + tokq * DM + h * 64 + 16 * db + 4 * q4) = w; }
        }
    }
    __syncthreads();
}
#define XB_TMO      128
#define XB_XCNT(j)  (256  + 64 * (j))
#define XB_XSUB(j)  (1280 + 64 * (j))
#define XB_XGEN(j)  (2304 + 64 * (j))
#define XB_TOP      3328
#define XB_TOPGEN   3392
#define XCD_BAR_WORDS 3456
#define XB_SPIN_CAP (1u << 18)

__device__ __forceinline__ unsigned xb_ld(unsigned* p)              { return __hip_atomic_load(p, __ATOMIC_RELAXED, __HIP_MEMORY_SCOPE_AGENT); }
__device__ __forceinline__ unsigned xb_add(unsigned* p, unsigned v) { return __hip_atomic_fetch_add(p, v, __ATOMIC_RELAXED, __HIP_MEMORY_SCOPE_AGENT); }
__device__ __forceinline__ unsigned xb_xcc_id() { return (unsigned)__builtin_amdgcn_s_getreg((3 << 11) | 20) & 0xFu; }
#define XB_SPIN(cond, bar) do { unsigned _sp = 0; while (cond) { __builtin_amdgcn_s_sleep(1); \
    if ((++_sp & 255u) == 0u) { if (xb_ld(&(bar)[XB_TMO])) break; if (_sp > XB_SPIN_CAP) { atomicAdd(&(bar)[XB_TMO], 1u); break; } } } } while (0)

struct XcdBarrier {
    unsigned* bar; unsigned x;
    volatile LAS unsigned* st;
};

__device__ __forceinline__ XcdBarrier xcd_barrier_post(unsigned* bar, volatile LAS unsigned* st) {
    XcdBarrier b; b.bar = bar; b.x = xb_xcc_id(); b.st = st;
    if (threadIdx.x == 0) (void)xb_add(&bar[XB_XCNT(b.x)], 1u);
    return b;
}
__device__ __forceinline__ void xcd_barrier_complete(unsigned* bar, unsigned x, unsigned& nloc, unsigned& nx) {
    const unsigned G = gridDim.x * gridDim.y * gridDim.z;
    unsigned sum, cnt, mine, sp = 0u;
    for (;;) {
        sum = 0u; cnt = 0u; mine = 0u;
#pragma unroll
        for (unsigned j = 0; j < 16; ++j) { const unsigned c = xb_ld(&bar[XB_XCNT(j)]); sum += c; cnt += (c > 0u) ? 1u : 0u; mine = (j == x) ? c : mine; }
        if (sum == G) break;
        __builtin_amdgcn_s_sleep(1);
        if ((++sp & 255u) == 0u) { if (xb_ld(&bar[XB_TMO])) break; if (sp > XB_SPIN_CAP) { atomicAdd(&bar[XB_TMO], 1u); break; } }
    }
    nloc = mine > 0u ? mine : 1u; nx = cnt > 0u ? cnt : 1u;
}

__device__ __forceinline__ void xcd_barrier(const XcdBarrier& b) {
    asm volatile("s_waitcnt vmcnt(0)" ::: "memory");
    __syncthreads();
    if (threadIdx.x == 0) {
        unsigned* bar = b.bar;
        __builtin_amdgcn_s_waitcnt(0);
        unsigned nloc = b.st[0], nx = b.st[1];
        if (nloc == 0u) { xcd_barrier_complete(bar, b.x, nloc, nx); b.st[0] = nloc; b.st[1] = nx; }
        const unsigned old = xb_add(&bar[XB_XSUB(b.x)], 1u);
        const unsigned gen = old / nloc;
        if (old + 1u == (gen + 1u) * nloc) {
            __builtin_amdgcn_fence(__ATOMIC_RELEASE, "agent");
            asm volatile("s_waitcnt vmcnt(0)" ::: "memory");
            const unsigned og = xb_add(&bar[XB_TOP], 1u);
            const unsigned tg = og / nx;
            if (og + 1u == (tg + 1u) * nx) xb_add(&bar[XB_TOPGEN], 1u);
            else XB_SPIN(xb_ld(&bar[XB_TOPGEN]) == tg, bar);
            __builtin_amdgcn_fence(__ATOMIC_ACQUIRE, "agent");
            xb_add(&bar[XB_XGEN(b.x)], 1u);
            asm volatile("s_waitcnt vmcnt(0)" ::: "memory");
        } else {
            XB_SPIN(xb_ld(&bar[XB_XGEN(b.x)]) == gen, bar);
            __builtin_amdgcn_fence(__ATOMIC_ACQUIRE, "agent");
            asm volatile("s_waitcnt vmcnt(0)" ::: "memory");
        }
    }
    __syncthreads();
}

constexpr size_t WS_BAR = 3 * MiB;
enum { I_X = 0, I_NMIX, I_NFFN, I_NFIN, I_HWIN, I_HBIN, I_HCW, I_HCB, I_FW1, I_FB1, I_FW2, I_FB2, I_FW3, I_FB3, I_FFREQ, I_FWOUT, I_DECAY, I_SKIP, I_HWOUT, I_HBOUT,
       I_NWQKV, I_NBQKV, I_RPB, I_NWO, I_NBO, I_WG, I_WU, I_WD };
__global__ void __launch_bounds__(512) fwd_kernel(Args args) {
    extern __shared__ __attribute__((aligned(16))) unsigned char lds_raw[];
    Frame F; F.lds = (LAS unsigned char*)lds_raw; F.tid = threadIdx.x; F.lane = F.tid & 63; F.wave = __builtin_amdgcn_readfirstlane(F.tid >> 6); F.G = gridDim.x; F.bid = blockIdx.x;
    cg::grid_group grid = cg::this_grid();
    volatile LAS unsigned* BST = (volatile LAS unsigned*)(F.lds + LDS_BYTES - 64);
    if (F.tid < 2) BST[F.tid] = 0u;
    __syncthreads();
    XcdBarrier xbar; xbar.bar = (unsigned*)(args.ws + WS_BAR); xbar.x = 0; xbar.st = BST;
#if MK_SINGLE
    xbar = xcd_barrier_post((unsigned*)(args.ws + WS_BAR), BST);
#endif
    unsigned char* ws = args.ws;
    const int lo = args.ph_lo, hi = args.ph_hi;
    float* part = (float*)(ws + WS_PART); float* rstd = (float*)(ws + WS_RSTD);
    bf16* Whin = (bf16*)(ws + WS_WHIN); bf16* Whout = (bf16*)(ws + WS_WHOUT); bf16* Wqkv = (bf16*)(ws + WS_WQKV); bf16* Wo = (bf16*)(ws + WS_WO);
    bf16* Wfo = (bf16*)(ws + WS_WFO); bf16* HF = (bf16*)(ws + WS_HF);
    bf16* XN = (bf16*)(ws + WS_XN); bf16* U = (bf16*)(ws + WS_U); bf16* Z = (bf16*)(ws + WS_Z); bf16* VT = (bf16*)(ws + WS_VT); bf16* UT = (bf16*)(ws + WS_UT); bf16* GT = (bf16*)(ws + WS_GT);
    float* X1 = args.out;
#define IN(k) (lo <= (k) && (k) < hi)
#ifndef PROBE_DOUBLE
#define PROBE_DOUBLE -1
#endif
#define REP(k) for (int rep_ = 0; rep_ < ((PROBE_DOUBLE) == (k) ? 2 : 1); ++rep_)
#define SEAM(k) do { if (IN(k) && IN((k) + 1)) xcd_barrier(xbar); } while (0)
    if (lo > hi) grid.sync();
    if (IN(0)) REP(0) {
        int base = 0;
        transpose_matrix(F, args.in[I_HWIN], 1024, 3072, args.in[I_NMIX], Whin, 0, base);
        transpose_matrix(F, args.in[I_HWOUT], 1024, 1024, nullptr, Whout, 0, base);
        transpose_matrix(F, args.in[I_NWQKV], 1024, 3072, args.in[I_NMIX] + 1024, Wqkv, 0, base);
        transpose_matrix(F, args.in[I_NWO], 1024, 1024, nullptr, Wo, 0, base);
        for (int l = 0; l < 2; ++l) {
            bf16* gu = (bf16*)(ws + (l ? WS_WGU1 : WS_WGU0)); bf16* wd = (bf16*)(ws + (l ? WS_WD1 : WS_WD0));
            transpose_matrix(F, args.in[I_WG] + (size_t)l * 1024 * FFH, 1024, FFH, args.in[I_NFFN] + l * 1024, gu, 1, base);
            transpose_matrix(F, args.in[I_WU] + (size_t)l * 1024 * FFH, 1024, FFH, args.in[I_NFFN] + l * 1024, gu, 2, base);
            transpose_matrix(F, args.in[I_WD] + (size_t)l * 1024 * FFH, FFH, 1024, nullptr, wd, 0, base);
        }
        { const float* wout = args.in[I_FWOUT];
          for (int idx = F.bid * 512 + F.tid; idx < 2048 * 128; idx += F.G * 512) { const int nn = idx >> 7, k = idx & 127; Wfo[idx] = k < 64 ? (bf16)f2bf(wout[k * 2048 + nn]) : (bf16)0; } }
        { const int gw = F.bid * 8 + F.wave, NGW = F.G * 8;
          for (int m = 4 * gw; m < MTOK; m += 4 * NGW) norm_rows4_to_bf16(args.in[I_X] + (size_t)m * DM, XN + (size_t)m * DM, F.lane); }
        filter_mlp(F, args.in[I_FW1], args.in[I_FB1], args.in[I_FW2], args.in[I_FB2], args.in[I_FW3], args.in[I_FB3], args.in[I_FFREQ], HF);
        __syncthreads();
    }
    SEAM(0);
    if (IN(1)) {
        { pg8::Gemm g{Whin, XN, 3072, MTOK, 1024}; pg8::StaticOrder S; S.init(3072, MTOK, F.G, F.bid);
          pg8::EpiT<0> E{Z, MTOK, args.in[I_HBIN], nullptr, 0.f};
          pg8::gemm_phase<pg8::EpiT<0>, pg8::StaticOrder, true, true>(F.lds, g, S, E); }
        { pg8::Gemm g{Wfo, HF, 2048, SEQL, 128}; pg8::StaticOrder S; S.init(2048, SEQL, F.G, F.bid);
          pg8::EpiT<2> E{GT, SEQL, args.in[I_DECAY], nullptr, 1.44269504089f / (float)(SEQL - 1)};
          pg8::gemm_phase<pg8::EpiT<2>, pg8::StaticOrder, true, true>(F.lds, g, S, E); }
    }
    SEAM(1);
    if (IN(2)) hyena_conv_phase<0>(F, Z, GT, args.in[I_HCW], args.in[I_HCB], args.in[I_SKIP], (float*)(ws + WS_XN), (float*)(ws + WS_U), UT);
#ifdef PROBE_FFT_VAR
    if (IN(2)) hyena_conv_phase<PROBE_FFT_VAR>(F, Z, GT, args.in[I_HCW], args.in[I_HCB], args.in[I_SKIP], (float*)(ws + WS_XN), (float*)(ws + WS_U), (bf16*)args.out);
#endif
    SEAM(2);
    if (IN(3)) REP(3) transpose_ut_phase(F, UT, U);
    SEAM(3);
    if (IN(4)) { pg8::Gemm g{U, Whout, MTOK, 1024, 1024}; pg8::StaticOrder S; S.init(MTOK, 1024, F.G, F.bid);
        pg8::EpiRes<true> E{args.in[I_X], XN, args.in[I_HBOUT], part};
        pg8::gemm_phase<pg8::EpiRes<true>, pg8::StaticOrder, true, true>(F.lds, g, S, E); }
    SEAM(4);
    if (IN(5)) { pg8::Gemm g{XN, (bf16*)(ws + WS_WGU0), MTOK, 2 * FFH, 1024}; pg8::StaticOrder S; S.init(MTOK, 2 * FFH, F.G, F.bid);
        pg8::EpiGU E{Z, part};
        pg8::gemm_phase<pg8::EpiGU, pg8::StaticOrder, true, true>(F.lds, g, S, E); }
    SEAM(5);
    if (IN(6)) { pg8::Gemm g{Z, (bf16*)(ws + WS_WD0), MTOK, 1024, FFH}; pg8::StaticOrder S; S.init(MTOK, 1024, F.G, F.bid);
        pg8::EpiRes<false> E{nullptr, XN, nullptr, part};
        pg8::gemm_phase<pg8::EpiRes<false>, pg8::StaticOrder, true, true>(F.lds, g, S, E); }
    SEAM(6);
    if (IN(7)) { for (int m = F.bid * 512 + F.tid; m < MTOK; m += F.G * 512) rstd[m] = pg8::rstd_from_partials(part, m); }
    SEAM(7);
    if (IN(8)) {
        { pg8::Gemm g{XN, Wqkv, MTOK, 2048, 1024}; pg8::StaticOrder S; S.init(MTOK, 2048, F.G, F.bid);
          pg8::EpiRowScale E{Z, 2048, args.in[I_NBQKV], rstd};
          pg8::gemm_phase<pg8::EpiRowScale, pg8::StaticOrder, true, true>(F.lds, g, S, E); }
        { pg8::Gemm g{Wqkv + (size_t)2048 * 1024, XN, 1024, MTOK, 1024}; pg8::StaticOrder S; S.init(1024, MTOK, F.G, F.bid);
          pg8::EpiT<1> E{VT, MTOK, args.in[I_NBQKV] + 2048, rstd, 0.f};
          pg8::gemm_phase<pg8::EpiT<1>, pg8::StaticOrder, true, true>(F.lds, g, S, E); }
    }
    SEAM(8);
    if (IN(9)) REP(9) na_phase(F, Z, VT, args.in[I_RPB], U);
    SEAM(9);
    if (IN(10)) { pg8::Gemm g{U, Wo, MTOK, 1024, 1024}; pg8::StaticOrder S; S.init(MTOK, 1024, F.G, F.bid);
        pg8::EpiRes<false> E{nullptr, XN, args.in[I_NBO], part};
        pg8::gemm_phase<pg8::EpiRes<false>, pg8::StaticOrder, true, true>(F.lds, g, S, E); }
    SEAM(10);
    if (IN(11)) { pg8::Gemm g{XN, (bf16*)(ws + WS_WGU1), MTOK, 2 * FFH, 1024}; pg8::StaticOrder S; S.init(MTOK, 2 * FFH, F.G, F.bid);
        pg8::EpiGU E{Z, part};
        pg8::gemm_phase<pg8::EpiGU, pg8::StaticOrder, true, true>(F.lds, g, S, E); }
    SEAM(11);
    if (IN(12)) { pg8::Gemm g{Z, (bf16*)(ws + WS_WD1), MTOK, 1024, FFH}; pg8::StaticOrder S; S.init(MTOK, 1024, F.G, F.bid);
        pg8::EpiRes<false> E{nullptr, XN, nullptr, part};
        pg8::gemm_phase<pg8::EpiRes<false>, pg8::StaticOrder, true, true>(F.lds, g, S, E); }
    SEAM(12);
    if (IN(13)) { const int gw = F.bid * 8 + F.wave, NGW = F.G * 8; const float* gf = args.in[I_NFIN];
        for (int m = gw; m < MTOK; m += NGW) { const float rs = pg8::rstd_from_partials(part, m);
            const v4u* xr = (const v4u*)(XN + (size_t)m * DM) + F.lane; f32x4* orow = (f32x4*)(X1 + (size_t)m * DM) + 2 * F.lane;
#pragma unroll
            for (int j = 0; j < 2; ++j) { const v4u w = xr[64 * j]; const f32x4 g0 = *((const f32x4*)gf + 2 * F.lane + 128 * j), g1 = *((const f32x4*)gf + 2 * F.lane + 128 * j + 1);
                const f32x4 a = (f32x4){bflo(w.x), bfhi(w.x), bflo(w.y), bfhi(w.y)}, c = (f32x4){bflo(w.z), bfhi(w.z), bflo(w.w), bfhi(w.w)};
                orow[128 * j] = a * rs * g0; orow[128 * j + 1] = c * rs * g1; } } }
#undef IN
#undef SEAM
}

extern "C" void kernel_launch(void* const* d_in, const int* in_sizes, int n_in, void* d_out, int out_size, void* d_ws, size_t ws_size, hipStream_t stream) {
    static int grid = 0;
    if (grid == 0) {
        if (n_in != 28 || out_size != MTOK * DM || ws_size < WS_END) { fprintf(stderr, "kernel_launch: unexpected shapes (n_in %d out %d ws %zu)\n", n_in, out_size, ws_size); grid = -1; return; }
        int dev = 0, cus = 0, per_cu = 0;
        hipGetDevice(&dev); hipDeviceGetAttribute(&cus, hipDeviceAttributeMultiprocessorCount, dev);
        if (hipFuncSetAttribute((const void*)fwd_kernel, hipFuncAttributeMaxDynamicSharedMemorySize, LDS_BYTES) != hipSuccess) { fprintf(stderr, "kernel_launch: hipFuncSetAttribute failed\n"); grid = -1; return; }
        if (hipOccupancyMaxActiveBlocksPerMultiprocessor(&per_cu, (const void*)fwd_kernel, 512, LDS_BYTES) != hipSuccess || per_cu < 1) { fprintf(stderr, "kernel_launch: occupancy query failed (%d)\n", per_cu); (void)hipGetLastError(); per_cu = 1; }
        grid = cus * 1;
        fprintf(stderr, "kernel_launch: cus %d per_cu %d grid %d\n", cus, per_cu, grid);
    }
    if (grid < 0) return;
    Args a{};
    for (int i = 0; i < 28; ++i) a.in[i] = (const float*)d_in[i];
    a.out = (float*)d_out; a.ws = (unsigned char*)d_ws;
#if MK_SINGLE
    (void)hipMemsetAsync((unsigned char*)d_ws + WS_BAR, 0, 16384, stream);
    a.ph_lo = 0; a.ph_hi = NPHASE;
    void* kargs[] = {&a};
    hipError_t e = hipLaunchCooperativeKernel((const void*)fwd_kernel, dim3(grid), dim3(512), kargs, LDS_BYTES, stream);
    if (e != hipSuccess) fprintf(stderr, "cooperative launch failed: %s (grid %d)\n", hipGetErrorString(e), grid);
#else
    for (int p = 0; p < NPHASE; ++p) { a.ph_lo = p; a.ph_hi = p + 1; hipLaunchKernelGGL(fwd_kernel, dim3(grid), dim3(512), LDS_BYTES, stream, a); }
#endif
}
```
